# Optimizing an MI355X kernel written in HIP

```python
import math
import jax, jax.numpy as jnp
from jax import lax
import numpy as np

D_MODEL = 1024
BATCH = 8
SEQ = 2048
DEPTH = 1

CHUNK = 64
PLE_DIM = 256
SG_BLOCK = 128
SG_GROUPS = 4
SG_WIDTH = 512
SG_GROUP_CH = SG_WIDTH // SG_GROUPS
SB_HEADS = 8
SB_HEAD_DIM = 64
SB_WIDTH = SB_HEADS * SB_HEAD_DIM
SB_QBLOCK = 128
IN_SIZES = (SG_WIDTH, SG_WIDTH, SB_WIDTH, SB_WIDTH, SB_WIDTH, D_MODEL, D_MODEL)
IN_PROJ_WIDTH = 2 * SG_WIDTH + 3 * SB_WIDTH + 2 * D_MODEL
IN_SPLITS = (SG_WIDTH, 2 * SG_WIDTH, 2 * SG_WIDTH + SB_WIDTH, 2 * SG_WIDTH + 2 * SB_WIDTH,
             2 * SG_WIDTH + 3 * SB_WIDTH, 2 * SG_WIDTH + 3 * SB_WIDTH + D_MODEL)
N_EXPERTS = 64
N_GROUPS = 8
TOPK_GROUPS = 4
TOP_K = 8
EXPERT_FF = 256
SHARED_FF = 256
ROUTED_SCALE = 2.5
MOE_BLOCK = 128
LN_EPS = 1e-5
DEEPNORM_ALPHA = (2.0 * DEPTH) ** 0.25
DEEPNORM_BETA = (8.0 * DEPTH) ** -0.25

kernel_name = "hybrid_sgmlp_stickbreak_moe_deepnorm"


def layer_norm(x, g, b):
    xf = x.astype(jnp.float32)
    mu = jnp.mean(xf, axis=-1, keepdims=True)
    xc = xf - mu
    var = jnp.mean(jnp.square(xc), axis=-1, keepdims=True)
    y = xc * lax.rsqrt(var + LN_EPS)
    return (y * g.astype(jnp.float32) + b.astype(jnp.float32)).astype(x.dtype)


def spatial_gating(u, v, ln_g, ln_b, w_s, b_s):
    bsz, seq, _ = u.shape
    nb = seq // SG_BLOCK
    v = layer_norm(v, ln_g, ln_b).reshape(bsz, nb, SG_BLOCK, SG_GROUPS, SG_GROUP_CH)
    pos = jnp.arange(SG_BLOCK)
    mask = (pos[None, :] // CHUNK) <= (pos[:, None] // CHUNK)
    w = jnp.where(mask[None], w_s, jnp.zeros_like(w_s))
    s = jnp.einsum('gij,bnjgc->bnigc', w, v) + b_s.T[None, None, :, :, None]
    return u * s.reshape(bsz, seq, SG_WIDTH)


def stick_breaking_attention(q, k, v):
    bsz, seq, _, _ = q.shape
    q = q.transpose(0, 2, 1, 3)
    k = k.transpose(0, 2, 1, 3)
    v = v.transpose(0, 2, 1, 3)
    scale = 1.0 / math.sqrt(SB_HEAD_DIM)
    outs = []
    for blk in range(seq // SB_QBLOCK):
        lo = blk * SB_QBLOCK
        hi = lo + SB_QBLOCK
        z = jnp.einsum('bhqd,bhkd->bhqk', q[:, :, lo:hi], k[:, :, :hi]).astype(jnp.float32) * scale
        t_idx = lo + jnp.arange(SB_QBLOCK)[:, None]
        s_idx = jnp.arange(hi)[None, :]
        causal = s_idx < t_idx
        log_1m = jnp.where(causal, jax.nn.log_sigmoid(-z), 0.0)
        tail = lax.cumsum(log_1m, axis=3, reverse=True) - log_1m
        a = jnp.where(causal, jnp.exp(jax.nn.log_sigmoid(z) + tail), 0.0)
        outs.append(jnp.einsum('bhqk,bhkd->bhqd', a.astype(v.dtype), v[:, :, :hi]))
    o = jnp.concatenate(outs, axis=2)
    return o.transpose(0, 2, 1, 3).reshape(bsz, seq, SB_WIDTH)


def moe_ffn(x, router_w, router_bias, w_gate, w_up, w_down, sh_gate, sh_up, sh_down):
    bsz, seq, dm = x.shape
    n_tok = bsz * seq
    xf = x.reshape(n_tok, dm)
    scores = jax.nn.sigmoid((xf @ router_w).astype(jnp.float32))
    sel = scores + router_bias.astype(jnp.float32)
    grp = jnp.sum(lax.top_k(sel.reshape(n_tok, N_GROUPS, N_EXPERTS // N_GROUPS), 2)[0], axis=-1)
    _, gidx = lax.top_k(grp, TOPK_GROUPS)
    gmask = jnp.any(gidx[:, :, None] == jnp.arange(N_GROUPS)[None, None, :], axis=1)
    emask = jnp.repeat(gmask, N_EXPERTS // N_GROUPS, axis=1)
    _, eidx = lax.top_k(jnp.where(emask, sel, -jnp.inf), TOP_K)
    wsel = jnp.take_along_axis(scores, eidx, axis=1)
    wsel = wsel / jnp.sum(wsel, axis=-1, keepdims=True) * ROUTED_SCALE
    n_assign = n_tok * TOP_K
    flat_e = eidx.reshape(n_assign).astype(jnp.int32)
    flat_tok = jnp.repeat(jnp.arange(n_tok, dtype=jnp.int32), TOP_K)
    flat_w = wsel.reshape(n_assign)
    order = jnp.argsort(flat_e)
    sorted_e = flat_e[order]
    counts = jnp.bincount(flat_e, length=N_EXPERTS).astype(jnp.int32)
    starts = jnp.cumsum(counts) - counts
    padded = (counts + MOE_BLOCK - 1) // MOE_BLOCK * MOE_BLOCK
    pad_ends = jnp.cumsum(padded)
    pad_starts = pad_ends - padded
    dest = pad_starts[sorted_e] + jnp.arange(n_assign, dtype=jnp.int32) - starts[sorted_e]
    n_blocks = n_assign // MOE_BLOCK + N_EXPERTS
    n_rows = n_blocks * MOE_BLOCK
    row_tok = jnp.full((n_rows,), n_tok, jnp.int32).at[dest].set(flat_tok[order])
    row_w = jnp.zeros((n_rows,), jnp.float32).at[dest].set(flat_w[order])
    block_e = jnp.minimum(jnp.searchsorted(pad_ends, jnp.arange(n_blocks, dtype=jnp.int32) * MOE_BLOCK,
                                           side='right'), N_EXPERTS - 1)
    x_pad = jnp.concatenate([xf, jnp.zeros((1, dm), xf.dtype)], axis=0)

    def expert_block(args):
        tok, e = args
        xb = x_pad[tok]
        hb = jax.nn.silu(xb @ w_gate[e]) * (xb @ w_up[e])
        return hb @ w_down[e]

    yb = lax.map(expert_block, (row_tok.reshape(n_blocks, MOE_BLOCK), block_e))
    yb = yb.reshape(n_rows, dm) * row_w[:, None].astype(yb.dtype)
    routed = jax.ops.segment_sum(yb, row_tok, num_segments=n_tok + 1)[:n_tok]
    shared = (jax.nn.silu(xf @ sh_gate) * (xf @ sh_up)) @ sh_down
    return (routed + shared).reshape(bsz, seq, dm)


def setup_inputs(seed: int = 0) -> dict:
    key = jax.random.key(seed)
    ks = jax.random.split(key, 26)
    L = DEPTH
    D = D_MODEL

    def nrm(k, shape, scale):
        return jax.random.normal(k, shape, jnp.float32) * scale

    return {
        "x": nrm(ks[0], (BATCH, SEQ, D), 1.0),
        "p": nrm(ks[1], (DEPTH, BATCH, SEQ, PLE_DIM), 1.0),
        "ln_in_g": 1.0 + nrm(ks[2], (D,), 0.02),
        "ln_in_b": nrm(ks[3], (D,), 0.02),
        "w_in": nrm(ks[4], (L, D, IN_PROJ_WIDTH), D ** -0.5),
        "sg_ln_g": 1.0 + nrm(ks[5], (L, SG_WIDTH), 0.02),
        "sg_ln_b": nrm(ks[6], (L, SG_WIDTH), 0.02),
        "sg_w_s": nrm(ks[7], (L, SG_GROUPS, SG_BLOCK, SG_BLOCK), SG_BLOCK ** -0.5),
        "sg_b_s": 1.0 + nrm(ks[8], (L, SG_GROUPS, SG_BLOCK), 0.1),
        "w_branch_a": nrm(ks[9], (L, SG_WIDTH, D), SG_WIDTH ** -0.5),
        "w_branch_b": nrm(ks[10], (L, SB_WIDTH, D), SB_WIDTH ** -0.5),
        "w_out": nrm(ks[11], (L, D, D), D ** -0.5 * DEEPNORM_BETA),
        "ln1_g": 1.0 + nrm(ks[12], (L, D), 0.02),
        "ln1_b": nrm(ks[13], (L, D), 0.02),
        "router_w": nrm(ks[14], (L, D, N_EXPERTS), D ** -0.5),
        "router_bias": nrm(ks[15], (L, N_EXPERTS), 0.01),
        "moe_w_gate": nrm(ks[16], (L, N_EXPERTS, D, EXPERT_FF), D ** -0.5),
        "moe_w_up": nrm(ks[17], (L, N_EXPERTS, D, EXPERT_FF), D ** -0.5),
        "moe_w_down": nrm(ks[18], (L, N_EXPERTS, EXPERT_FF, D), EXPERT_FF ** -0.5 * DEEPNORM_BETA),
        "sh_w_gate": nrm(ks[19], (L, D, SHARED_FF), D ** -0.5),
        "sh_w_up": nrm(ks[20], (L, D, SHARED_FF), D ** -0.5),
        "sh_w_down": nrm(ks[21], (L, SHARED_FF, D), SHARED_FF ** -0.5 * DEEPNORM_BETA),
        "ple_w_proj": nrm(ks[22], (L, PLE_DIM, D), PLE_DIM ** -0.5 * DEEPNORM_BETA),
        "ple_w_gate": nrm(ks[23], (L, D, D), D ** -0.5),
        "ln2_g": 1.0 + nrm(ks[24], (L, D), 0.02),
        "ln2_b": nrm(ks[25], (L, D), 0.02),
    }


def reference(x, p, ln_in_g, ln_in_b, w_in, sg_ln_g, sg_ln_b, sg_w_s, sg_b_s, w_branch_a, w_branch_b,
              w_out, ln1_g, ln1_b, router_w, router_bias, moe_w_gate, moe_w_up, moe_w_down,
              sh_w_gate, sh_w_up, sh_w_down, ple_w_proj, ple_w_gate, ln2_g, ln2_b):
    bsz, seq, _ = x.shape
    h = layer_norm(x, ln_in_g, ln_in_b)
    for i in range(DEPTH):
        proj = h @ w_in[i]
        u, v_sg, q, k, v_sb, g_a, g_b = jnp.split(proj, IN_SPLITS, axis=-1)
        y_a = spatial_gating(jax.nn.gelu(u), jax.nn.gelu(v_sg), sg_ln_g[i], sg_ln_b[i], sg_w_s[i], sg_b_s[i])
        y_b = stick_breaking_attention(q.reshape(bsz, seq, SB_HEADS, SB_HEAD_DIM),
                                       k.reshape(bsz, seq, SB_HEADS, SB_HEAD_DIM),
                                       v_sb.reshape(bsz, seq, SB_HEADS, SB_HEAD_DIM))
        merged = jax.nn.sigmoid(g_a) * (y_a @ w_branch_a[i]) + jax.nn.sigmoid(g_b) * (y_b @ w_branch_b[i])
        h = layer_norm(DEEPNORM_ALPHA * h + merged @ w_out[i], ln1_g[i], ln1_b[i])
        r = DEEPNORM_ALPHA * h + moe_ffn(h, router_w[i], router_bias[i], moe_w_gate[i], moe_w_up[i],
                                         moe_w_down[i], sh_w_gate[i], sh_w_up[i], sh_w_down[i])
        r = r + jax.nn.sigmoid(r @ ple_w_gate[i]) * (p[i] @ ple_w_proj[i])
        h = layer_norm(r, ln2_g[i], ln2_b[i])
    return h
```

```cpp
#include <hip/hip_runtime.h>
#include <stdint.h>
#include <math.h>

constexpr int T = 16384, D = 1024, SEQ = 2048, NBATCH = 8, NPROJ = 4608;
constexpr int SGW = 512, NHEAD = 8, HD = 64, NEXP = 64, EFF = 256, PLE = 256;
constexpr int ECAP = 16384;
constexpr float LN_EPS = 1e-5f;
constexpr float ALPHA = 1.189207115002721f;
constexpr float QSCALE = 0.125f * 1.4426950408889634f;
constexpr float ROUTED_SCALE = 2.5f;

typedef unsigned short bf16_t;
__device__ __forceinline__ float bf2f(bf16_t v) { return __uint_as_float(((unsigned)v) << 16); }
__device__ __forceinline__ bf16_t f2bf(float f) { unsigned u = __float_as_uint(f); return (bf16_t)((u + 0x7fffu + ((u >> 16) & 1u)) >> 16); }

constexpr size_t MiB = 1u << 20;
constexpr size_t WS_CTL = 0;
constexpr size_t WS_HB = 1 * MiB;
constexpr size_t WS_YAB = 33 * MiB;
constexpr size_t WS_VG = 65 * MiB;
constexpr size_t WS_Z = 33 * MiB;
constexpr size_t WS_HBX = 33 * MiB;
constexpr size_t WS_Y = 113 * MiB;
constexpr size_t WS_R2 = 113 * MiB;
constexpr size_t WS_RACC = 113 * MiB;
constexpr size_t WS_WGU = 113 * MiB;
constexpr size_t WS_WIN = 178 * MiB, WS_WAB = 187 * MiB, WS_WOUT = 189 * MiB, WS_SGW = 191 * MiB;
constexpr size_t WS_KV = 192 * MiB;
constexpr size_t WS_GA = 224 * MiB;
constexpr size_t WS_GB = 256 * MiB;
constexpr size_t WS_PP = 273 * MiB;
constexpr size_t WS_SCR = 288 * MiB;
constexpr size_t WS_END = 305 * MiB;
constexpr size_t OUT_WD = 0;
constexpr size_t OUT_PB = 33 * MiB;
constexpr size_t OUT_WPG = 41 * MiB, OUT_WPP = 43 * MiB;
constexpr size_t OUT_ROWTOK = 44 * MiB, OUT_ROWW = 48 * MiB, OUT_TOKSLOT = 52 * MiB;
constexpr int CW_BAR = 4096;
constexpr int CW_CNT = 16384;

struct Ptrs {
    const float *x, *p, *ln_in_g, *ln_in_b, *w_in, *sg_ln_g, *sg_ln_b, *sg_w_s, *sg_b_s, *w_a, *w_b, *w_out, *ln1_g, *ln1_b, *router_w, *router_bias,
        *moe_g, *moe_u, *moe_d, *sh_g, *sh_u, *sh_d, *ple_proj, *ple_gate, *ln2_g, *ln2_b;
    float* out; unsigned char* ws;
};

__device__ __forceinline__ float wave_sum(float v) {
#pragma unroll
    for (int o = 1; o < 64; o <<= 1) v += __shfl_xor(v, o);
    return v;
}
template <bool OUT_BF16> __global__ void __launch_bounds__(256) n_ln(const float* src, const float* g, const float* b, void* dst, int rows) {
    const int row = blockIdx.x * 4 + (threadIdx.x >> 6), lane = threadIdx.x & 63;
    if (row >= rows) return;
    const float* xr = src + (size_t)row * D;
    float v[16]; float s = 0.f;
#pragma unroll
    for (int j = 0; j < 16; ++j) { v[j] = xr[lane + 64 * j]; s += v[j]; }
    const float mean = wave_sum(s) * (1.f / D); float q = 0.f;
#pragma unroll
    for (int j = 0; j < 16; ++j) { v[j] -= mean; q += v[j] * v[j]; }
    const float rstd = 1.f / sqrtf(wave_sum(q) * (1.f / D) + LN_EPS);
#pragma unroll
    for (int j = 0; j < 16; ++j) { const int c = lane + 64 * j; const float y = v[j] * rstd * g[c] + b[c];
        if (OUT_BF16) ((bf16_t*)dst)[(size_t)row * D + c] = f2bf(y); else ((float*)dst)[(size_t)row * D + c] = y; }
}
__global__ void n_cvt_bf16(const float* src, bf16_t* dst, size_t n) { size_t i = (size_t)blockIdx.x * blockDim.x + threadIdx.x; if (i < n) dst[i] = f2bf(src[i]); }

struct NG { const bf16_t* A1; const bf16_t* A2; const float* B1; const float* B2; int lda, ldb, M, N, K, pad; };
static NG mkNG(const bf16_t* A1, const bf16_t* A2, int lda, const float* B1, const float* B2, int ldb, int M, int N, int K) { NG g; g.A1 = A1; g.A2 = A2; g.B1 = B1; g.B2 = B2; g.lda = lda; g.ldb = ldb; g.M = M; g.N = N; g.K = K; g.pad = 0; return g; }
template <bool DUAL, class Epi> __global__ void __launch_bounds__(256) n_gemm(NG g, Epi epi) {
    __shared__ float As1[16][65], Bs1[16][65], As2[16][65], Bs2[16][65];
    int M = g.M; const bf16_t* A1 = g.A1; const bf16_t* A2 = g.A2; const float* B1 = g.B1; const float* B2 = g.B2;
    if (!epi.setup(blockIdx.z, M, A1, A2, B1, B2)) return;
    const int m0 = blockIdx.y * 64, n0 = blockIdx.x * 64;
    if (m0 >= M) return;
    const int tx = threadIdx.x & 15, ty = threadIdx.x >> 4;
    float acc1[4][4] = {}, acc2[4][4] = {};
    for (int k0 = 0; k0 < g.K; k0 += 16) {
        for (int i = threadIdx.x; i < 1024; i += 256) {
            const int r = i >> 4, kk = i & 15; const int m = m0 + r;
            float a1 = 0.f, a2 = 0.f;
            if (m < M) { const long ar = epi.arow(m); a1 = bf2f(A1[ar * g.lda + k0 + kk]); if (DUAL) a2 = bf2f(A2[ar * g.lda + k0 + kk]); }
            As1[kk][r] = a1; if (DUAL) As2[kk][r] = a2;
            const int kb = i >> 6, c = i & 63;
            Bs1[kb][c] = B1[(size_t)(k0 + kb) * g.ldb + n0 + c]; if (DUAL) Bs2[kb][c] = B2[(size_t)(k0 + kb) * g.ldb + n0 + c];
        }
        __syncthreads();
#pragma unroll
        for (int kk = 0; kk < 16; ++kk) {
            float a[4], b[4], a2[4], b2[4];
#pragma unroll
            for (int i = 0; i < 4; ++i) { a[i] = As1[kk][ty * 4 + i]; b[i] = Bs1[kk][tx * 4 + i]; if (DUAL) { a2[i] = As2[kk][ty * 4 + i]; b2[i] = Bs2[kk][tx * 4 + i]; } }
#pragma unroll
            for (int i = 0; i < 4; ++i)
#pragma unroll
                for (int j = 0; j < 4; ++j) { acc1[i][j] += a[i] * b[j]; if (DUAL) acc2[i][j] += a2[i] * b2[j]; }
        }
        __syncthreads();
    }
#pragma unroll
    for (int i = 0; i < 4; ++i)
#pragma unroll
        for (int j = 0; j < 4; ++j) { const int m = m0 + ty * 4 + i, n = n0 + tx * 4 + j; if (m < M) epi.store(m, n, acc1[i][j], acc2[i][j]); }
}
struct EpiBase { __device__ bool setup(int, int&, const bf16_t*&, const bf16_t*&, const float*&, const float*&) { return true; } __device__ long arow(int m) const { return m; } };

__device__ __forceinline__ float gelu_tanh(float x) { const float y = 0.7978845608028654f * (x + 0.044715f * x * x * x); return x / (1.f + __expf(-2.f * y)); }
__device__ __forceinline__ float sigmoidf_(float x) { return 1.f / (1.f + __expf(-x)); }

struct EpiP1 : EpiBase { bf16_t *yab, *vg, *kv, *ga, *gb;
    __device__ void store(int m, int n, float a, float) const {
        if (n < 512) yab[(size_t)m * 1024 + n] = f2bf(gelu_tanh(a));
        else if (n < 1024) vg[(size_t)m * 512 + (n - 512)] = f2bf(gelu_tanh(a));
        else if (n < 1536) yab[(size_t)m * 1024 + 512 + (n - 1024)] = f2bf(a * QSCALE);
        else if (n < 2560) kv[(size_t)m * 1024 + (n - 1536)] = f2bf(a);
        else if (n < 3584) ga[(size_t)m * 1024 + (n - 2560)] = f2bf(sigmoidf_(a));
        else gb[(size_t)m * 1024 + (n - 3584)] = f2bf(sigmoidf_(a));
    } };
struct EpiP3 : EpiBase { bf16_t *ga; const bf16_t* gb;
    __device__ void store(int m, int n, float a1, float a2) const { const size_t o = (size_t)m * 1024 + n; ga[o] = f2bf(bf2f(ga[o]) * a1 + bf2f(gb[o]) * a2); } };
struct EpiP4 : EpiBase { const bf16_t* h; float* z;
    __device__ void store(int m, int n, float a, float) const { const size_t o = (size_t)m * 1024 + n; z[o] = ALPHA * bf2f(h[o]) + a; } };
__device__ __forceinline__ int tile_base_of(const unsigned* cnt, int e) { int tb = 0; for (int i = 0; i < e && i < NEXP; ++i) tb += ((int)cnt[64 * i] + 255) >> 8; return tb; }
struct EpiP6 { const unsigned* cnt; const int* rowtok; const float* roww; bf16_t* hbx; const float *mg, *mu, *sg, *su; int e, rowbase;
    __device__ bool setup(int z, int& M, const bf16_t*&, const bf16_t*&, const float*& B1, const float*& B2) {
        e = z; rowbase = tile_base_of(cnt, e) * 256;
        if (e < NEXP) { M = (int)cnt[64 * e]; B1 = mg + (size_t)e * D * EFF; B2 = mu + (size_t)e * D * EFF; } else { M = T; B1 = sg; B2 = su; }
        return true; }
    __device__ long arow(int m) const { return e < NEXP ? rowtok[(size_t)e * ECAP + m] : m; }
    __device__ void store(int m, int n, float a1, float a2) const { const float w = e < NEXP ? roww[(size_t)e * ECAP + m] : 1.f;
        hbx[(size_t)(rowbase + m) * EFF + n] = f2bf(w * (a1 / (1.f + __expf(-a1))) * a2); } };
struct EpiP7 { const unsigned* cnt; const int* rowtok; float* racc; const float *md, *sd; int e, rowbase;
    __device__ bool setup(int z, int& M, const bf16_t*& A1, const bf16_t*&, const float*& B1, const float*&) {
        e = z; rowbase = tile_base_of(cnt, e) * 256; A1 += (size_t)rowbase * EFF;
        if (e < NEXP) { M = (int)cnt[64 * e]; B1 = md + (size_t)e * EFF * D; } else { M = T; B1 = sd; }
        return true; }
    __device__ long arow(int m) const { return m; }
    __device__ void store(int m, int n, float a, float) const { const int tok = e < NEXP ? rowtok[(size_t)e * ECAP + m] : m; atomicAdd(&racc[(size_t)tok * D + n], a); } };
struct EpiPP : EpiBase { bf16_t* pp; __device__ void store(int m, int n, float a, float) const { pp[(size_t)m * 1024 + n] = f2bf(a); } };
struct EpiP9 : EpiBase { const bf16_t *r, *pp; float* r2;
    __device__ void store(int m, int n, float a, float) const { const size_t o = (size_t)m * 1024 + n; r2[o] = bf2f(r[o]) + sigmoidf_(a) * bf2f(pp[o]); } };

__global__ void __launch_bounds__(256) n_sg_stats(const bf16_t* vg, float* st) {
    const int row = blockIdx.x * 4 + (threadIdx.x >> 6), lane = threadIdx.x & 63;
    float v[8]; float s = 0.f;
#pragma unroll
    for (int j = 0; j < 8; ++j) { v[j] = bf2f(vg[(size_t)row * SGW + lane + 64 * j]); s += v[j]; }
    const float mean = wave_sum(s) * (1.f / SGW); float q = 0.f;
#pragma unroll
    for (int j = 0; j < 8; ++j) { const float d = v[j] - mean; q += d * d; }
    const float rstd = 1.f / sqrtf(wave_sum(q) * (1.f / SGW) + LN_EPS);
    if (lane == 0) { st[2 * row] = mean; st[2 * row + 1] = rstd; }
}
__global__ void __launch_bounds__(256) n_sg(bf16_t* yab, const bf16_t* vg, const float* st, const float* lg, const float* lb, const float* ws_, const float* bs) {
    const size_t idx = (size_t)blockIdx.x * 256 + threadIdx.x;
    const int t = (int)(idx >> 9), ch = (int)(idx & 511), g = ch >> 7, i = t & 127, t0 = t - i;
    const int jmax = (i < 64) ? 64 : 128;
    float s = 0.f;
    for (int j = 0; j < jmax; ++j) { const int tj = t0 + j; const float vn = (bf2f(vg[(size_t)tj * SGW + ch]) - st[2 * tj]) * st[2 * tj + 1] * lg[ch] + lb[ch];
        s += ws_[((size_t)g * 128 + i) * 128 + j] * bf2f(f2bf(vn)); }
    s += bs[g * 128 + i];
    yab[(size_t)t * 1024 + ch] = f2bf(bf2f(yab[(size_t)t * 1024 + ch]) * s);
}
__global__ void __launch_bounds__(256) n_attn(bf16_t* yab, const bf16_t* kv) {
    const int gw = blockIdx.x * 4 + (threadIdx.x >> 6), lane = threadIdx.x & 63;
    const int tok = gw >> 3, h = gw & 7, b = tok / SEQ, t = tok % SEQ;
    float qv[64];
#pragma unroll
    for (int d = 0; d < 64; ++d) qv[d] = bf2f(yab[(size_t)tok * 1024 + 512 + h * 64 + d]);
    float o = 0.f, carry = 0.f;
    for (int c = (t - 1) >> 6; c >= 0 && t > 0; --c) {
        const int s = c * 64 + lane; const bool valid = s < t;
        const bf16_t* kr = kv + (size_t)(b * SEQ + (valid ? s : 0)) * 1024 + h * 64;
        float zl = 0.f;
#pragma unroll
        for (int d = 0; d < 64; ++d) zl += qv[d] * bf2f(kr[d]);
        const float z = zl * 0.6931471805599453f;
        const float sp = fmaxf(z, 0.f) + log1pf(__expf(-fabsf(z)));
        const float l1m = valid ? -sp : 0.f;
        float suf = l1m;
#pragma unroll
        for (int off = 1; off < 64; off <<= 1) { const float y = __shfl_down(suf, off); if (lane + off < 64) suf += y; }
        const float tail = carry + suf - l1m;
        const float a = valid ? __expf((z - sp) + tail) : 0.f;
        carry += __shfl(suf, 0);
        for (int l = 0; l < 64; ++l) { const float al = __shfl(a, l); const int sl = c * 64 + l; if (sl < t) o += al * bf2f(kv[(size_t)(b * SEQ + sl) * 1024 + 512 + h * 64 + lane]); }
    }
    yab[(size_t)tok * 1024 + 512 + h * 64 + lane] = f2bf(o);
}

__global__ void __launch_bounds__(512) k_route(const float* z, const float* g1, const float* b1, bf16_t* hb, const float* rw, const float* rbias,
                                               unsigned* cnt, int* rowtok, float* roww, int* tokslot) {
    extern __shared__ __attribute__((aligned(16))) unsigned char dyn_lds[];
    float (*hrow)[4][1024] = (float (*)[4][1024])dyn_lds;
    unsigned* lcnt = (unsigned*)(dyn_lds + 131072); unsigned* lbase = lcnt + 64;
    const int wave = threadIdx.x >> 6, lane = threadIdx.x & 63, tok0 = blockIdx.x * 64 + wave * 8;
    if (threadIdx.x < 64) lcnt[threadIdx.x] = 0u;
    __syncthreads();
    unsigned* slot_er = lbase + 64;
    float* slot_w = (float*)(slot_er + 512);
    for (int pass = 0; pass < 2; ++pass) {
        for (int r = 0; r < 4; ++r) {
            const int tok = tok0 + pass * 4 + r; const float* zr = z + (size_t)tok * D;
            float v[16]; float s = 0.f;
#pragma unroll
            for (int j = 0; j < 16; ++j) { v[j] = zr[lane + 64 * j]; s += v[j]; }
            const float mean = wave_sum(s) * (1.f / D); float q = 0.f;
#pragma unroll
            for (int j = 0; j < 16; ++j) { v[j] -= mean; q += v[j] * v[j]; }
            const float rstd = 1.f / sqrtf(wave_sum(q) * (1.f / D) + LN_EPS);
#pragma unroll
            for (int j = 0; j < 16; ++j) { const int c = lane + 64 * j; const float y = v[j] * rstd * g1[c] + b1[c]; hrow[wave][r][c] = y; hb[(size_t)tok * D + c] = f2bf(y); }
        }
        __builtin_amdgcn_s_waitcnt(0);
        float acc0 = 0.f, acc1 = 0.f, acc2 = 0.f, acc3 = 0.f;
        for (int d = 0; d < D; d += 4) {
            const float w0 = rw[(size_t)(d + 0) * NEXP + lane], w1 = rw[(size_t)(d + 1) * NEXP + lane], w2 = rw[(size_t)(d + 2) * NEXP + lane], w3 = rw[(size_t)(d + 3) * NEXP + lane];
            float4 hv;
            hv = *(const float4*)&hrow[wave][0][d]; acc0 += hv.x * w0 + hv.y * w1 + hv.z * w2 + hv.w * w3;
            hv = *(const float4*)&hrow[wave][1][d]; acc1 += hv.x * w0 + hv.y * w1 + hv.z * w2 + hv.w * w3;
            hv = *(const float4*)&hrow[wave][2][d]; acc2 += hv.x * w0 + hv.y * w1 + hv.z * w2 + hv.w * w3;
            hv = *(const float4*)&hrow[wave][3][d]; acc3 += hv.x * w0 + hv.y * w1 + hv.z * w2 + hv.w * w3;
        }
        for (int r = 0; r < 4; ++r) {
            const float lg = r == 0 ? acc0 : r == 1 ? acc1 : r == 2 ? acc2 : acc3;
            const int e = lane; const float score = 1.f / (1.f + expf(-lg)); const float sel = score + rbias[e];
            int r8 = 0;
#pragma unroll
            for (int x = 1; x < 8; ++x) { const float o = __shfl_xor(sel, x); const int oi = e ^ x; r8 += (o > sel || (o == sel && oi < e)) ? 1 : 0; }
            float gs = r8 < 2 ? sel : 0.f; gs += __shfl_xor(gs, 1); gs += __shfl_xor(gs, 2); gs += __shfl_xor(gs, 4);
            int gr = 0; const int g = e >> 3;
#pragma unroll
            for (int x = 1; x < 8; ++x) { const float o = __shfl_xor(gs, 8 * x); const int og = g ^ x; gr += (o > gs || (o == gs && og < g)) ? 1 : 0; }
            const float ms = gr < 4 ? sel : -INFINITY;
            int rk = 0;
            for (int x = 1; x < 64; ++x) { const float o = __shfl_xor(ms, x); const int oi = e ^ x; rk += (o > ms || (o == ms && oi < e)) ? 1 : 0; }
            const bool chosen = rk < 8;
            const float wsum = wave_sum(chosen ? score : 0.f);
            if (chosen) { const int tl = wave * 8 + pass * 4 + r; const unsigned lr = atomicAdd(&lcnt[e], 1u);
                slot_er[tl * 8 + rk] = ((unsigned)e << 16) | lr; slot_w[tl * 8 + rk] = score / wsum * ROUTED_SCALE; }
        }
    }
    __syncthreads();
    if (threadIdx.x < 64) lbase[threadIdx.x] = atomicAdd(&cnt[64 * threadIdx.x], lcnt[threadIdx.x]);
    __syncthreads();
    { const int tl = threadIdx.x >> 3, k = threadIdx.x & 7, tok = blockIdx.x * 64 + tl; const unsigned er = slot_er[tl * 8 + k]; const int e = (int)(er >> 16); const unsigned pos = lbase[e] + (er & 0xffffu);
      rowtok[(size_t)e * ECAP + pos] = tok; roww[(size_t)e * ECAP + pos] = slot_w[tl * 8 + k]; tokslot[tok * 8 + k] = (e << 16) | (int)pos; }
}
__global__ void n_racc_init(const bf16_t* hb, float* racc) { const size_t i = (size_t)blockIdx.x * 256 + threadIdx.x; racc[i] = ALPHA * bf2f(hb[i]); }
__global__ void n_racc_fin(const float* racc, bf16_t* hb) { const size_t i = (size_t)blockIdx.x * 256 + threadIdx.x; hb[i] = f2bf(racc[i]); }

extern "C" void kernel_launch(void* const* d_in, const int* in_sizes, int n_in, void* d_out, int out_size, void* d_ws, size_t ws_size, hipStream_t stream) {
    Ptrs P{};
    const float** pp = (const float**)&P;
    for (int i = 0; i < 26; ++i) pp[i] = (const float*)d_in[i];
    P.out = (float*)d_out; P.ws = (unsigned char*)d_ws;
    unsigned char* ws = P.ws; unsigned char* ob = (unsigned char*)d_out;
    bf16_t* HB = (bf16_t*)(ws + WS_HB); bf16_t* YAB = (bf16_t*)(ws + WS_YAB); bf16_t* VG = (bf16_t*)(ws + WS_VG); bf16_t* KV = (bf16_t*)(ws + WS_KV);
    bf16_t* GA = (bf16_t*)(ws + WS_GA); bf16_t* GB = (bf16_t*)(ws + WS_GB); float* Z = (float*)(ws + WS_Z); bf16_t* HBX = (bf16_t*)(ws + WS_HBX);
    float* RACC = (float*)(ws + WS_RACC); float* R2 = (float*)(ws + WS_R2); bf16_t* PPB = (bf16_t*)(ws + WS_PP); float* SCR = (float*)(ws + WS_SCR);
    bf16_t* PB = (bf16_t*)(ob + OUT_PB); int* ROWTOK = (int*)(ob + OUT_ROWTOK); float* ROWW = (float*)(ob + OUT_ROWW); int* TOKSLOT = (int*)(ob + OUT_TOKSLOT);
    unsigned* CTL = (unsigned*)(ws + WS_CTL); unsigned* CNT = CTL + CW_CNT;
    hipMemsetAsync(ws + WS_CTL, 0, 1 * MiB, stream);
    n_ln<true><<<T / 4, 256, 0, stream>>>(P.x, P.ln_in_g, P.ln_in_b, HB, T);
    n_cvt_bf16<<<(T * PLE) / 256, 256, 0, stream>>>(P.p, PB, (size_t)T * PLE);
    { NG g = mkNG(HB, HB, 1024, P.w_in, P.w_in, NPROJ, T, NPROJ, D); EpiP1 e; e.yab = YAB; e.vg = VG; e.kv = KV; e.ga = GA; e.gb = GB;
      n_gemm<false, EpiP1><<<dim3(NPROJ / 64, T / 64, 1), 256, 0, stream>>>(g, e); }
    n_sg_stats<<<T / 4, 256, 0, stream>>>(VG, SCR);
    n_sg<<<(T * SGW) / 256, 256, 0, stream>>>(YAB, VG, SCR, P.sg_ln_g, P.sg_ln_b, P.sg_w_s, P.sg_b_s);
    n_attn<<<(T * NHEAD) / 4, 256, 0, stream>>>(YAB, KV);
    { NG g = mkNG(YAB, YAB + 512, 1024, P.w_a, P.w_b, D, T, D, 512); EpiP3 e; e.ga = GA; e.gb = GB; n_gemm<true, EpiP3><<<dim3(D / 64, T / 64, 1), 256, 0, stream>>>(g, e); }
    { NG g = mkNG(GA, GA, 1024, P.w_out, P.w_out, D, T, D, D); EpiP4 e; e.h = HB; e.z = Z; n_gemm<false, EpiP4><<<dim3(D / 64, T / 64, 1), 256, 0, stream>>>(g, e); }
    hipFuncSetAttribute((const void*)k_route, hipFuncAttributeMaxDynamicSharedMemorySize, 131072 + 512 + 4096);
    k_route<<<T / 64, 512, 131072 + 512 + 4096, stream>>>(Z, P.ln1_g, P.ln1_b, HB, P.router_w, P.router_bias, CNT, ROWTOK, ROWW, TOKSLOT);
    { NG g = mkNG(HB, HB, 1024, nullptr, nullptr, EFF, T, EFF, D); EpiP6 e; e.cnt = CNT; e.rowtok = ROWTOK; e.roww = ROWW; e.hbx = HBX; e.mg = P.moe_g; e.mu = P.moe_u; e.sg = P.sh_g; e.su = P.sh_u; e.e = 0; e.rowbase = 0;
      n_gemm<true, EpiP6><<<dim3(EFF / 64, T / 64, NEXP + 1), 256, 0, stream>>>(g, e); }
    n_racc_init<<<(T * D) / 256, 256, 0, stream>>>(HB, RACC);
    { NG g = mkNG(HBX, HBX, EFF, nullptr, nullptr, D, T, D, EFF); EpiP7 e; e.cnt = CNT; e.rowtok = ROWTOK; e.racc = RACC; e.md = P.moe_d; e.sd = P.sh_d; e.e = 0; e.rowbase = 0;
      n_gemm<false, EpiP7><<<dim3(D / 64, T / 64, NEXP + 1), 256, 0, stream>>>(g, e); }
    n_racc_fin<<<(T * D) / 256, 256, 0, stream>>>(RACC, HB);
    { NG g = mkNG(PB, PB, PLE, P.ple_proj, P.ple_proj, D, T, D, PLE); EpiPP e; e.pp = PPB; n_gemm<false, EpiPP><<<dim3(D / 64, T / 64, 1), 256, 0, stream>>>(g, e); }
    { NG g = mkNG(HB, HB, 1024, P.ple_gate, P.ple_gate, D, T, D, D); EpiP9 e; e.r = HB; e.pp = PPB; e.r2 = R2; n_gemm<false, EpiP9><<<dim3(D / 64, T / 64, 1), 256, 0, stream>>>(g, e); }
    n_ln<false><<<T / 4, 256, 0, stream>>>(R2, P.ln2_g, P.ln2_b, P.out, T);
}
```

```cpp
#include <hip/hip_runtime.h>
#include <stdint.h>
#include <math.h>
#include <string.h>

constexpr int T = 16384, D = 1024, SEQ = 2048, NBATCH = 8, NPROJ = 4608;
constexpr int SGW = 512, NHEAD = 8, HD = 64, NEXP = 64, EFF = 256, PLE = 256;
constexpr int ECAP = 16384;
constexpr float LN_EPS = 1e-5f;
constexpr float ALPHA = 1.189207115002721f;
constexpr float QSCALE = 0.125f * 1.4426950408889634f;
constexpr float ROUTED_SCALE = 2.5f;

typedef unsigned short bf16_t;
__device__ __forceinline__ float bf2f(bf16_t v) { return __uint_as_float(((unsigned)v) << 16); }
__device__ __forceinline__ bf16_t f2bf(float f) { unsigned u = __float_as_uint(f); return (bf16_t)((u + 0x7fffu + ((u >> 16) & 1u)) >> 16); }

constexpr size_t MiB = 1u << 20;
constexpr size_t WS_CTL = 0;
constexpr size_t WS_HB = 1 * MiB;
constexpr size_t WS_YAB = 33 * MiB;
constexpr size_t WS_VG = 65 * MiB;
constexpr size_t WS_Z = 33 * MiB;
constexpr size_t WS_HBX = 33 * MiB;
constexpr size_t WS_Y = 113 * MiB;
constexpr size_t WS_R2 = 113 * MiB;
constexpr size_t WS_RACC = 113 * MiB;
constexpr size_t WS_WGU = 113 * MiB;
constexpr size_t WS_WIN = 178 * MiB, WS_WAB = 187 * MiB, WS_WOUT = 189 * MiB, WS_SGW = 191 * MiB;
constexpr size_t WS_KV = 192 * MiB;
constexpr size_t WS_GA = 224 * MiB;
constexpr size_t WS_GB = 256 * MiB;
constexpr size_t WS_PP = 273 * MiB;
constexpr size_t WS_SCR = 288 * MiB;
constexpr size_t WS_END = 305 * MiB;
constexpr size_t OUT_WD = 0;
constexpr size_t OUT_PB = 33 * MiB;
constexpr size_t OUT_WPG = 41 * MiB, OUT_WPP = 43 * MiB;
constexpr size_t OUT_ROWTOK = 44 * MiB, OUT_ROWW = 48 * MiB, OUT_TOKSLOT = 52 * MiB;
constexpr int CW_BAR = 4096;
constexpr int CW_CNT = 65536;

struct Ptrs {
    const float *x, *p, *ln_in_g, *ln_in_b, *w_in, *sg_ln_g, *sg_ln_b, *sg_w_s, *sg_b_s, *w_a, *w_b, *w_out, *ln1_g, *ln1_b, *router_w, *router_bias,
        *moe_g, *moe_u, *moe_d, *sh_g, *sh_u, *sh_d, *ple_proj, *ple_gate, *ln2_g, *ln2_b;
    float* out; unsigned char* ws;
};

__device__ __forceinline__ float wave_sum(float v) {
#pragma unroll
    for (int o = 1; o < 64; o <<= 1) v += __shfl_xor(v, o);
    return v;
}
template <bool OUT_BF16> __global__ void __launch_bounds__(256) n_ln(const float* src, const float* g, const float* b, void* dst, int rows) {
    const int row = blockIdx.x * 4 + (threadIdx.x >> 6), lane = threadIdx.x & 63;
    if (row >= rows) return;
    const float* xr = src + (size_t)row * D;
    float v[16]; float s = 0.f;
#pragma unroll
    for (int j = 0; j < 16; ++j) { v[j] = xr[lane + 64 * j]; s += v[j]; }
    const float mean = wave_sum(s) * (1.f / D); float q = 0.f;
#pragma unroll
    for (int j = 0; j < 16; ++j) { v[j] -= mean; q += v[j] * v[j]; }
    const float rstd = 1.f / sqrtf(wave_sum(q) * (1.f / D) + LN_EPS);
#pragma unroll
    for (int j = 0; j < 16; ++j) { const int c = lane + 64 * j; const float y = v[j] * rstd * g[c] + b[c];
        if (OUT_BF16) ((bf16_t*)dst)[(size_t)row * D + c] = f2bf(y); else ((float*)dst)[(size_t)row * D + c] = y; }
}
__global__ void n_cvt_bf16(const float* src, bf16_t* dst, size_t n) { size_t i = (size_t)blockIdx.x * blockDim.x + threadIdx.x; if (i < n) dst[i] = f2bf(src[i]); }

struct NG { const bf16_t* A1; const bf16_t* A2; const float* B1; const float* B2; int lda, ldb, M, N, K, pad; };
static NG mkNG(const bf16_t* A1, const bf16_t* A2, int lda, const float* B1, const float* B2, int ldb, int M, int N, int K) { NG g; g.A1 = A1; g.A2 = A2; g.B1 = B1; g.B2 = B2; g.lda = lda; g.ldb = ldb; g.M = M; g.N = N; g.K = K; g.pad = 0; return g; }
template <bool DUAL, class Epi> __global__ void __launch_bounds__(256) n_gemm(NG g, Epi epi) {
    __shared__ float As1[16][65], Bs1[16][65], As2[16][65], Bs2[16][65];
    int M = g.M; const bf16_t* A1 = g.A1; const bf16_t* A2 = g.A2; const float* B1 = g.B1; const float* B2 = g.B2;
    if (!epi.setup(blockIdx.z, M, A1, A2, B1, B2)) return;
    const int m0 = blockIdx.y * 64, n0 = blockIdx.x * 64;
    if (m0 >= M) return;
    const int tx = threadIdx.x & 15, ty = threadIdx.x >> 4;
    float acc1[4][4] = {}, acc2[4][4] = {};
    for (int k0 = 0; k0 < g.K; k0 += 16) {
        for (int i = threadIdx.x; i < 1024; i += 256) {
            const int r = i >> 4, kk = i & 15; const int m = m0 + r;
            float a1 = 0.f, a2 = 0.f;
            if (m < M) { const long ar = epi.arow(m); a1 = bf2f(A1[ar * g.lda + k0 + kk]); if (DUAL) a2 = bf2f(A2[ar * g.lda + k0 + kk]); }
            As1[kk][r] = a1; if (DUAL) As2[kk][r] = a2;
            const int kb = i >> 6, c = i & 63;
            Bs1[kb][c] = B1[(size_t)(k0 + kb) * g.ldb + n0 + c]; if (DUAL) Bs2[kb][c] = B2[(size_t)(k0 + kb) * g.ldb + n0 + c];
        }
        __syncthreads();
#pragma unroll
        for (int kk = 0; kk < 16; ++kk) {
            float a[4], b[4], a2[4], b2[4];
#pragma unroll
            for (int i = 0; i < 4; ++i) { a[i] = As1[kk][ty * 4 + i]; b[i] = Bs1[kk][tx * 4 + i]; if (DUAL) { a2[i] = As2[kk][ty * 4 + i]; b2[i] = Bs2[kk][tx * 4 + i]; } }
#pragma unroll
            for (int i = 0; i < 4; ++i)
#pragma unroll
                for (int j = 0; j < 4; ++j) { acc1[i][j] += a[i] * b[j]; if (DUAL) acc2[i][j] += a2[i] * b2[j]; }
        }
        __syncthreads();
    }
#pragma unroll
    for (int i = 0; i < 4; ++i)
#pragma unroll
        for (int j = 0; j < 4; ++j) { const int m = m0 + ty * 4 + i, n = n0 + tx * 4 + j; if (m < M) epi.store(m, n, acc1[i][j], acc2[i][j]); }
}
struct EpiBase { __device__ bool setup(int, int&, const bf16_t*&, const bf16_t*&, const float*&, const float*&) { return true; } __device__ long arow(int m) const { return m; } };

__device__ __forceinline__ float gelu_tanh(float x) { const float y = 0.7978845608028654f * (x + 0.044715f * x * x * x); return x / (1.f + __expf(-2.f * y)); }
__device__ __forceinline__ float sigmoidf_(float x) { return 1.f / (1.f + __expf(-x)); }

struct EpiP1 : EpiBase { bf16_t *yab, *vg, *kv, *ga, *gb;
    __device__ void store(int m, int n, float a, float) const {
        if (n < 512) yab[(size_t)m * 1024 + n] = f2bf(gelu_tanh(a));
        else if (n < 1024) vg[(size_t)m * 512 + (n - 512)] = f2bf(gelu_tanh(a));
        else if (n < 1536) yab[(size_t)m * 1024 + 512 + (n - 1024)] = f2bf(a * QSCALE);
        else if (n < 2560) kv[(size_t)m * 1024 + (n - 1536)] = f2bf(a);
        else if (n < 3584) ga[(size_t)m * 1024 + (n - 2560)] = f2bf(sigmoidf_(a));
        else gb[(size_t)m * 1024 + (n - 3584)] = f2bf(sigmoidf_(a));
    } };
struct EpiP3 : EpiBase { bf16_t *ga; const bf16_t* gb;
    __device__ void store(int m, int n, float a1, float a2) const { const size_t o = (size_t)m * 1024 + n; ga[o] = f2bf(bf2f(ga[o]) * a1 + bf2f(gb[o]) * a2); } };
struct EpiP4 : EpiBase { const bf16_t* h; float* z;
    __device__ void store(int m, int n, float a, float) const { const size_t o = (size_t)m * 1024 + n; z[o] = ALPHA * bf2f(h[o]) + a; } };
__device__ __forceinline__ int tile_base_of(const unsigned* cnt, int e) { int tb = 0; for (int i = 0; i < e && i < NEXP; ++i) tb += ((int)cnt[64 * i] + 255) >> 8; return tb; }
struct EpiP6 { const unsigned* cnt; const int* rowtok; const float* roww; bf16_t* hbx; const float *mg, *mu, *sg, *su; int e, rowbase;
    __device__ bool setup(int z, int& M, const bf16_t*&, const bf16_t*&, const float*& B1, const float*& B2) {
        e = z; rowbase = tile_base_of(cnt, e) * 256;
        if (e < NEXP) { M = (int)cnt[64 * e]; B1 = mg + (size_t)e * D * EFF; B2 = mu + (size_t)e * D * EFF; } else { M = T; B1 = sg; B2 = su; }
        return true; }
    __device__ long arow(int m) const { return e < NEXP ? rowtok[(size_t)e * ECAP + m] : m; }
    __device__ void store(int m, int n, float a1, float a2) const { const float w = e < NEXP ? roww[(size_t)e * ECAP + m] : 1.f;
        hbx[(size_t)(rowbase + m) * EFF + n] = f2bf(w * (a1 / (1.f + __expf(-a1))) * a2); } };
struct EpiP7 { const unsigned* cnt; const int* rowtok; float* racc; const float *md, *sd; int e, rowbase;
    __device__ bool setup(int z, int& M, const bf16_t*& A1, const bf16_t*&, const float*& B1, const float*&) {
        e = z; rowbase = tile_base_of(cnt, e) * 256; A1 += (size_t)rowbase * EFF;
        if (e < NEXP) { M = (int)cnt[64 * e]; B1 = md + (size_t)e * EFF * D; } else { M = T; B1 = sd; }
        return true; }
    __device__ long arow(int m) const { return m; }
    __device__ void store(int m, int n, float a, float) const { const int tok = e < NEXP ? rowtok[(size_t)e * ECAP + m] : m; atomicAdd(&racc[(size_t)tok * D + n], a); } };
struct EpiPP : EpiBase { bf16_t* pp; __device__ void store(int m, int n, float a, float) const { pp[(size_t)m * 1024 + n] = f2bf(a); } };
struct EpiP9 : EpiBase { const bf16_t *r, *pp; float* r2;
    __device__ void store(int m, int n, float a, float) const { const size_t o = (size_t)m * 1024 + n; r2[o] = bf2f(r[o]) + sigmoidf_(a) * bf2f(pp[o]); } };

__global__ void __launch_bounds__(256) n_sg_stats(const bf16_t* vg, float* st) {
    const int row = blockIdx.x * 4 + (threadIdx.x >> 6), lane = threadIdx.x & 63;
    float v[8]; float s = 0.f;
#pragma unroll
    for (int j = 0; j < 8; ++j) { v[j] = bf2f(vg[(size_t)row * SGW + lane + 64 * j]); s += v[j]; }
    const float mean = wave_sum(s) * (1.f / SGW); float q = 0.f;
#pragma unroll
    for (int j = 0; j < 8; ++j) { const float d = v[j] - mean; q += d * d; }
    const float rstd = 1.f / sqrtf(wave_sum(q) * (1.f / SGW) + LN_EPS);
    if (lane == 0) { st[2 * row] = mean; st[2 * row + 1] = rstd; }
}
__global__ void __launch_bounds__(256) n_sg(bf16_t* yab, const bf16_t* vg, const float* st, const float* lg, const float* lb, const float* ws_, const float* bs) {
    const size_t idx = (size_t)blockIdx.x * 256 + threadIdx.x;
    const int t = (int)(idx >> 9), ch = (int)(idx & 511), g = ch >> 7, i = t & 127, t0 = t - i;
    const int jmax = (i < 64) ? 64 : 128;
    float s = 0.f;
    for (int j = 0; j < jmax; ++j) { const int tj = t0 + j; const float vn = (bf2f(vg[(size_t)tj * SGW + ch]) - st[2 * tj]) * st[2 * tj + 1] * lg[ch] + lb[ch];
        s += ws_[((size_t)g * 128 + i) * 128 + j] * bf2f(f2bf(vn)); }
    s += bs[g * 128 + i];
    yab[(size_t)t * 1024 + ch] = f2bf(bf2f(yab[(size_t)t * 1024 + ch]) * s);
}
__global__ void __launch_bounds__(256) n_attn(bf16_t* yab, const bf16_t* kv) {
    const int gw = blockIdx.x * 4 + (threadIdx.x >> 6), lane = threadIdx.x & 63;
    const int tok = gw >> 3, h = gw & 7, b = tok / SEQ, t = tok % SEQ;
    float qv[64];
#pragma unroll
    for (int d = 0; d < 64; ++d) qv[d] = bf2f(yab[(size_t)tok * 1024 + 512 + h * 64 + d]);
    float o = 0.f, carry = 0.f;
    for (int c = (t - 1) >> 6; c >= 0 && t > 0; --c) {
        const int s = c * 64 + lane; const bool valid = s < t;
        const bf16_t* kr = kv + (size_t)(b * SEQ + (valid ? s : 0)) * 1024 + h * 64;
        float zl = 0.f;
#pragma unroll
        for (int d = 0; d < 64; ++d) zl += qv[d] * bf2f(kr[d]);
        const float z = zl * 0.6931471805599453f;
        const float sp = fmaxf(z, 0.f) + log1pf(__expf(-fabsf(z)));
        const float l1m = valid ? -sp : 0.f;
        float suf = l1m;
#pragma unroll
        for (int off = 1; off < 64; off <<= 1) { const float y = __shfl_down(suf, off); if (lane + off < 64) suf += y; }
        const float tail = carry + suf - l1m;
        const float a = valid ? __expf((z - sp) + tail) : 0.f;
        carry += __shfl(suf, 0);
        for (int l = 0; l < 64; ++l) { const float al = __shfl(a, l); const int sl = c * 64 + l; if (sl < t) o += al * bf2f(kv[(size_t)(b * SEQ + sl) * 1024 + 512 + h * 64 + lane]); }
    }
    yab[(size_t)tok * 1024 + 512 + h * 64 + lane] = f2bf(o);
}

__device__ __forceinline__ void route_block(unsigned char* dyn_lds, int blk, const float* z, const float* g1, const float* b1, bf16_t* hb, const float* rw, const float* rbias,
                                               unsigned* cnt, int* rowtok, float* roww, int* tokslot) {
    float (*hrow)[4][1024] = (float (*)[4][1024])dyn_lds;
    unsigned* lcnt = (unsigned*)(dyn_lds + 131072 + 1024); unsigned* lbase = lcnt + 64;
    const int wave = threadIdx.x >> 6, lane = threadIdx.x & 63, tok0 = blk * 64 + wave * 8;
    if (threadIdx.x < 64) lcnt[threadIdx.x] = 0u;
    __syncthreads();
    unsigned* slot_er = lbase + 64;
    float* slot_w = (float*)(slot_er + 512);
    for (int pass = 0; pass < 2; ++pass) {
        for (int r = 0; r < 4; ++r) {
            const int tok = tok0 + pass * 4 + r; const float* zr = z + (size_t)tok * D;
            float v[16]; float s = 0.f;
#pragma unroll
            for (int j = 0; j < 16; ++j) { v[j] = zr[lane + 64 * j]; s += v[j]; }
            const float mean = wave_sum(s) * (1.f / D); float q = 0.f;
#pragma unroll
            for (int j = 0; j < 16; ++j) { v[j] -= mean; q += v[j] * v[j]; }
            const float rstd = 1.f / sqrtf(wave_sum(q) * (1.f / D) + LN_EPS);
#pragma unroll
            for (int j = 0; j < 16; ++j) { const int c = lane + 64 * j; const float y = v[j] * rstd * g1[c] + b1[c]; hrow[wave][r][c] = y; hb[(size_t)tok * D + c] = f2bf(y); }
        }
        __builtin_amdgcn_s_waitcnt(0);
        float acc0 = 0.f, acc1 = 0.f, acc2 = 0.f, acc3 = 0.f;
        for (int d = 0; d < D; d += 4) {
            const float w0 = rw[(size_t)(d + 0) * NEXP + lane], w1 = rw[(size_t)(d + 1) * NEXP + lane], w2 = rw[(size_t)(d + 2) * NEXP + lane], w3 = rw[(size_t)(d + 3) * NEXP + lane];
            float4 hv;
            hv = *(const float4*)&hrow[wave][0][d]; acc0 += hv.x * w0 + hv.y * w1 + hv.z * w2 + hv.w * w3;
            hv = *(const float4*)&hrow[wave][1][d]; acc1 += hv.x * w0 + hv.y * w1 + hv.z * w2 + hv.w * w3;
            hv = *(const float4*)&hrow[wave][2][d]; acc2 += hv.x * w0 + hv.y * w1 + hv.z * w2 + hv.w * w3;
            hv = *(const float4*)&hrow[wave][3][d]; acc3 += hv.x * w0 + hv.y * w1 + hv.z * w2 + hv.w * w3;
        }
        for (int r = 0; r < 4; ++r) {
            const float lg = r == 0 ? acc0 : r == 1 ? acc1 : r == 2 ? acc2 : acc3;
            const int e = lane; const float score = 1.f / (1.f + expf(-lg)); const float sel = score + rbias[e];
            int r8 = 0;
#pragma unroll
            for (int x = 1; x < 8; ++x) { const float o = __shfl_xor(sel, x); const int oi = e ^ x; r8 += (o > sel || (o == sel && oi < e)) ? 1 : 0; }
            float gs = r8 < 2 ? sel : 0.f; gs += __shfl_xor(gs, 1); gs += __shfl_xor(gs, 2); gs += __shfl_xor(gs, 4);
            int gr = 0; const int g = e >> 3;
#pragma unroll
            for (int x = 1; x < 8; ++x) { const float o = __shfl_xor(gs, 8 * x); const int og = g ^ x; gr += (o > gs || (o == gs && og < g)) ? 1 : 0; }
            const float ms = gr < 4 ? sel : -INFINITY;
            int rk = 0;
            for (int x = 1; x < 64; ++x) { const float o = __shfl_xor(ms, x); const int oi = e ^ x; rk += (o > ms || (o == ms && oi < e)) ? 1 : 0; }
            const bool chosen = rk < 8;
            const float wsum = wave_sum(chosen ? score : 0.f);
            if (chosen) { const int tl = wave * 8 + pass * 4 + r; const unsigned lr = atomicAdd(&lcnt[e], 1u);
                slot_er[tl * 8 + rk] = ((unsigned)e << 16) | lr; slot_w[tl * 8 + rk] = score / wsum * ROUTED_SCALE; }
        }
    }
    __syncthreads();
    if (threadIdx.x < 64) lbase[threadIdx.x] = atomicAdd(&cnt[64 * threadIdx.x], lcnt[threadIdx.x]);
    __syncthreads();
    { const int tl = threadIdx.x >> 3, k = threadIdx.x & 7, tok = blk * 64 + tl; const unsigned er = slot_er[tl * 8 + k]; const int e = (int)(er >> 16); const unsigned pos = lbase[e] + (er & 0xffffu);
      rowtok[(size_t)e * ECAP + pos] = tok; roww[(size_t)e * ECAP + pos] = slot_w[tl * 8 + k]; tokslot[tok * 8 + k] = (e << 16) | (int)pos; }
}
__global__ void __launch_bounds__(512) k_route(const float* z, const float* g1, const float* b1, bf16_t* hb, const float* rw, const float* rbias, unsigned* cnt, int* rowtok, float* roww, int* tokslot) {
    extern __shared__ __attribute__((aligned(16))) unsigned char dyn_lds_k[];
    route_block(dyn_lds_k, blockIdx.x, z, g1, b1, hb, rw, rbias, cnt, rowtok, roww, tokslot);
}
__global__ void n_racc_init(const bf16_t* hb, float* racc) { const size_t i = (size_t)blockIdx.x * 256 + threadIdx.x; racc[i] = ALPHA * bf2f(hb[i]); }
__global__ void n_racc_fin(const float* racc, bf16_t* hb) { const size_t i = (size_t)blockIdx.x * 256 + threadIdx.x; hb[i] = f2bf(racc[i]); }


#define LAS __attribute__((address_space(3)))
#define GAS __attribute__((address_space(1)))
typedef short bf16x8 __attribute__((ext_vector_type(8)));
typedef float f32x4 __attribute__((ext_vector_type(4)));
typedef float f32x2 __attribute__((ext_vector_type(2)));
typedef unsigned u32x4 __attribute__((ext_vector_type(4)));
typedef unsigned u32x2 __attribute__((ext_vector_type(2)));
constexpr int NWAVES = 8, NTHREADS = 512;
constexpr int RING_BYTES = 131072;
constexpr int LDSCTL_OFF = RING_BYTES, MISC_OFF = LDSCTL_OFF + 320;
constexpr int GT_OFF = RING_BYTES + 1024;
constexpr int GW_OFF = GT_OFF + 8192;
constexpr int LDS_BYTES = 155648;
constexpr int TT_OFF = GW_OFF + 8192;
static_assert(TT_OFF + 1024 + 512 <= LDS_BYTES, "LDS map");

__device__ __forceinline__ unsigned cvt_pk_bf16(float lo, float hi) { unsigned r; asm volatile("v_cvt_pk_bf16_f32 %0, %1, %2" : "=v"(r) : "v"(lo), "v"(hi)); return r; }
__device__ __forceinline__ float bflo(unsigned w) { return __uint_as_float(w << 16); }
__device__ __forceinline__ float bfhi(unsigned w) { return __uint_as_float(w & 0xffff0000u); }
__device__ __forceinline__ float fast_rcp(float x) { return __builtin_amdgcn_rcpf(x); }
__device__ __forceinline__ float fast_exp2(float x) { return __builtin_amdgcn_exp2f(x); }
__device__ __forceinline__ float sigmoid_fast(float x) { return fast_rcp(1.f + fast_exp2(-1.4426950408889634f * x)); }
__device__ __forceinline__ float gelu_fast(float x) { const float y = x + 0.044715f * x * x * x; return x * fast_rcp(1.f + fast_exp2(-2.302208198f * y)); }

#define XB_TMO      128
#define XB_XCNT(j)  (256  + 64 * (j))
#define XB_XSUB(j)  (1280 + 64 * (j))
#define XB_XGEN(j)  (2304 + 64 * (j))
#define XB_TOP      3328
#define XB_TOPGEN   3392
#define XCD_BAR_WORDS 3456
#define XB_SPIN_CAP (1u << 18)
__device__ __forceinline__ unsigned xb_ld(unsigned* p)              { return __hip_atomic_load(p, __ATOMIC_RELAXED, __HIP_MEMORY_SCOPE_AGENT); }
__device__ __forceinline__ unsigned xb_add(unsigned* p, unsigned v) { return __hip_atomic_fetch_add(p, v, __ATOMIC_RELAXED, __HIP_MEMORY_SCOPE_AGENT); }
__device__ __forceinline__ unsigned xb_xcc_id() { return (unsigned)__builtin_amdgcn_s_getreg((3 << 11) | 20) & 0xFu; }
#define XB_SPIN(cond, bar) do { unsigned _sp = 0; while (cond) { __builtin_amdgcn_s_sleep(1); \
    if ((++_sp & 255u) == 0u) { if (xb_ld(&(bar)[XB_TMO])) break; if (_sp > XB_SPIN_CAP) { atomicAdd(&(bar)[XB_TMO], 1u); break; } } } } while (0)
struct XcdBarrier { unsigned* bar; unsigned x; volatile LAS unsigned* st; };
__device__ __forceinline__ XcdBarrier xcd_barrier_post(unsigned* bar, volatile LAS unsigned* st) {
    XcdBarrier b; b.bar = bar; b.x = xb_xcc_id(); b.st = st;
    if (threadIdx.x == 0) (void)xb_add(&bar[XB_XCNT(b.x)], 1u);
    return b;
}
__device__ __forceinline__ void xcd_barrier_complete(unsigned* bar, unsigned x, unsigned& nloc, unsigned& nx) {
    const unsigned G = gridDim.x * gridDim.y * gridDim.z;
    unsigned sum, cnt, mine, sp = 0u;
    for (;;) {
        sum = 0u; cnt = 0u; mine = 0u;
#pragma unroll
        for (unsigned j = 0; j < 16; ++j) { const unsigned c = xb_ld(&bar[XB_XCNT(j)]); sum += c; cnt += (c > 0u) ? 1u : 0u; mine = (j == x) ? c : mine; }
        if (sum == G) break;
        __builtin_amdgcn_s_sleep(1);
        if ((++sp & 255u) == 0u) { if (xb_ld(&bar[XB_TMO])) break; if (sp > XB_SPIN_CAP) { atomicAdd(&bar[XB_TMO], 1u); break; } }
    }
    nloc = mine > 0u ? mine : 1u; nx = cnt > 0u ? cnt : 1u;
}
__device__ __forceinline__ void xcd_barrier(const XcdBarrier& b) {
    asm volatile("s_waitcnt vmcnt(0)" ::: "memory");
    __syncthreads();
    if (threadIdx.x == 0) {
        unsigned* bar = b.bar;
        __builtin_amdgcn_s_waitcnt(0);
        unsigned nloc = b.st[0], nx = b.st[1];
        if (nloc == 0u) { xcd_barrier_complete(bar, b.x, nloc, nx); b.st[0] = nloc; b.st[1] = nx; }
        const unsigned old = xb_add(&bar[XB_XSUB(b.x)], 1u);
        const unsigned gen = old / nloc;
        if (old + 1u == (gen + 1u) * nloc) {
            __builtin_amdgcn_fence(__ATOMIC_RELEASE, "agent");
            asm volatile("s_waitcnt vmcnt(0)" ::: "memory");
            const unsigned og = xb_add(&bar[XB_TOP], 1u);
            const unsigned tg = og / nx;
            if (og + 1u == (tg + 1u) * nx) xb_add(&bar[XB_TOPGEN], 1u);
            else XB_SPIN(xb_ld(&bar[XB_TOPGEN]) == tg, bar);
            __builtin_amdgcn_fence(__ATOMIC_ACQUIRE, "agent");
            xb_add(&bar[XB_XGEN(b.x)], 1u);
            asm volatile("s_waitcnt vmcnt(0)" ::: "memory");
        } else {
            XB_SPIN(xb_ld(&bar[XB_XGEN(b.x)]) == gen, bar);
            __builtin_amdgcn_fence(__ATOMIC_ACQUIRE, "agent");
            asm volatile("s_waitcnt vmcnt(0)" ::: "memory");
        }
    }
    __syncthreads();
}

namespace pg8 {
constexpr int BM = 256, BK = 64, HALF = 128, HTB = HALF * BK * 2, STAGE_BYTES = 8 * HTB, NXCD = 8, WGM = 8;
__host__ __device__ __forceinline__ int lds_byte(int r, int c) { const int st = (r >> 4) * 2 + (c >> 5), rr = r & 15, cc = c & 31, ob = rr * 64 + cc * 2; return st * 1024 + (ob ^ (((ob >> 9) & 1) << 5)); }
__host__ __device__ __forceinline__ void stage_rc(int b, int& R, int& C) { const int st = b / 1024, sb = b % 1024, swz = sb ^ (((sb >> 9) & 1) << 5); R = (st >> 1) * 16 + swz / 64; C = (st & 1) * 32 + (swz % 64) / 2; }
__host__ __device__ __forceinline__ int perm32(int rho) { const int n = rho >> 4, i = rho & 15; return 8 * (i >> 2) + 4 * n + (i & 3); }
struct Unit { const char* A; const char* B; int pm, pn, row0, aux; };
struct DenseOrder {
    const char* A; const char* Bt; int nM, nN, nwg, G, c, K;
    __device__ void init(const void* A_, const void* Bt_, int M, int N, int K_, int G_, int c_) { A = (const char*)A_; Bt = (const char*)Bt_; nM = M / BM; nN = N / BM; nwg = nM * nN; G = G_; c = c_; K = K_; }
    static constexpr bool GATHER = false;
    __device__ bool next(int i, Unit& u) const {
        const long L = (long)i * G + c; if (L >= nwg) return false;
        int wgid = (int)L; { const int q = nwg / NXCD, r = nwg % NXCD, xcd = wgid % NXCD, off = wgid / NXCD; wgid = (xcd < r ? xcd * (q + 1) : r * (q + 1) + (xcd - r) * q) + off; }
        const int nig = WGM * nN, gid = wgid / nig, fm = gid * WGM, gsz = (nM - fm) < WGM ? (nM - fm) : WGM;
        u.pm = fm + ((wgid % nig) % gsz); u.pn = (wgid % nig) / gsz; u.row0 = u.pm * BM; u.aux = 0;
        u.A = A + (size_t)u.pm * BM * K * 2; u.B = Bt + (size_t)u.pn * BM * K * 2; return true;
    }
    __device__ __forceinline__ void offsets(int, unsigned (&)[2][2], const int (&)[2], const int (&)[2]) const {}
};

template <class Epi, class Sched, bool ALIGN_EPI>
__device__ __forceinline__ void gemm_phase(LAS unsigned char* lds, const int K, const Sched& S, const Epi& E) {
    const int tid = threadIdx.x, wid = __builtin_amdgcn_readfirstlane(tid >> 6), lane = tid & 63, wr = wid >> 2, wc = wid & 3, fr = lane & 15, fq = lane >> 4;
    const int nt = K / BK;
    unsigned voffA[2][2], voffAn[2][2], voffB[2]; int Rr[2], Cc[2];
    const size_t kstep = (size_t)(BK * 2);
    const size_t hstep = (size_t)HALF * K * 2;
#pragma unroll
    for (int i = 0; i < 2; ++i) { int R, C; stage_rc(tid * 16 + i * 8192, R, C); const int Rb = Epi::PERM ? ((R & ~31) + perm32(R & 31)) : R; Rr[i] = R; Cc[i] = C;
        voffB[i] = (unsigned)(Rb * K + C) * 2u;
#pragma unroll
        for (int h = 0; h < 2; ++h) { voffA[h][i] = (unsigned)((h * HALF + R) * K + C) * 2u; voffAn[h][i] = voffA[h][i]; } }
    const unsigned ldsw = (unsigned)wid * 1024u;
    const int aoff = lds_byte(wr * 64 + fr, fq * 8), boff = lds_byte(wc * 32 + fr, fq * 8);
#define PG8_SA(b, h) (((b) * 2 + (h)) * HTB)
#define PG8_SB(b, h) ((4 + (b) * 2 + (h)) * HTB)
#define PG8_STAGE_B(bufoff, gbase) do { _Pragma("unroll") for (int _i = 0; _i < 2; ++_i) \
        __builtin_amdgcn_global_load_lds((const unsigned*)((const char*)(gbase) + voffB[_i]), (LAS unsigned*)(lds + (bufoff) + ldsw + _i * 8192), 16, 0, 0); } while (0)
#define PG8_STAGE_A(bufoff, gbase, VO, h) do { _Pragma("unroll") for (int _i = 0; _i < 2; ++_i) \
        __builtin_amdgcn_global_load_lds((const unsigned*)((const char*)(gbase) + (VO)[h][_i]), (LAS unsigned*)(lds + (bufoff) + ldsw + _i * 8192), 16, 0, 0); } while (0)
#define PG8_LDA(dst, b, h) do { _Pragma("unroll") for (int m = 0; m < 4; ++m) _Pragma("unroll") for (int k = 0; k < 2; ++k) dst[m][k] = *(const LAS bf16x8*)(lds + PG8_SA(b, h) + aoff + m * 2048 + k * 1024); } while (0)
#define PG8_LDB(dst, b, h) do { _Pragma("unroll") for (int n = 0; n < 2; ++n) _Pragma("unroll") for (int k = 0; k < 2; ++k) dst[n][k] = *(const LAS bf16x8*)(lds + PG8_SB(b, h) + boff + n * 2048 + k * 1024); } while (0)
#define PG8_MMA(ai, bj, At, Bt) do { __builtin_amdgcn_s_setprio(1); _Pragma("unroll") for (int m = 0; m < 4; ++m) _Pragma("unroll") for (int n = 0; n < 2; ++n) _Pragma("unroll") for (int k = 0; k < 2; ++k) \
        acc[ai][bj][m][n] = __builtin_amdgcn_mfma_f32_16x16x32_bf16(Bt[n][k], At[m][k], acc[ai][bj][m][n], 0, 0, 0); __builtin_amdgcn_s_setprio(0); } while (0)
#define PG8_WAIT_V(n) asm volatile("s_waitcnt vmcnt(" #n ")" ::: "memory")
#define PG8_WAIT_L(n) asm volatile("s_waitcnt lgkmcnt(" #n ")" ::: "memory")
#define PG8_BAR __builtin_amdgcn_s_barrier()
#define PG8_SCHED __builtin_amdgcn_sched_barrier(0)
    Unit cur, nxt; int ui = 0;
    if (!S.next(0, cur)) return;
    if constexpr (Sched::GATHER) S.offsets(0, voffA, Rr, Cc);
    f32x4 acc[2][2][4][2];
#pragma unroll
    for (int a = 0; a < 2; ++a)
#pragma unroll
        for (int b = 0; b < 2; ++b)
#pragma unroll
            for (int m = 0; m < 4; ++m)
#pragma unroll
                for (int n = 0; n < 2; ++n) acc[a][b][m][n] = (f32x4){0.f, 0.f, 0.f, 0.f};
    bf16x8 At[4][2], B0[2][2], B1[2][2];
    const char* cA = cur.A; const char* cB = cur.B;
    PG8_STAGE_B(PG8_SB(0, 0), cB); PG8_STAGE_B(PG8_SB(0, 1), cB + hstep); PG8_STAGE_A(PG8_SA(0, 0), cA, voffA, 0); PG8_STAGE_A(PG8_SA(0, 1), cA, voffA, 1);
    if (wr == 1) PG8_BAR;
    PG8_WAIT_V(2); PG8_BAR;
    PG8_STAGE_B(PG8_SB(1, 0), cB + kstep); PG8_STAGE_A(PG8_SA(1, 0), cA + kstep, voffA, 0); PG8_STAGE_B(PG8_SB(1, 1), cB + hstep + kstep);
    PG8_WAIT_V(6); PG8_BAR;
    for (;;) {
        const bool has_next = S.next(ui + 1, nxt);
        if constexpr (Sched::GATHER) { if (has_next) S.offsets(ui + 1, voffAn, Rr, Cc); }
        const char* nA = has_next ? nxt.A : cA; const char* nB = has_next ? nxt.B : cB;
#pragma nounroll
        for (int t = 0; t < nt; t += 2) {
            const bool last = (t == nt - 2);
            if constexpr (Epi::MID) { if (t == nt / 2) E.mid(acc, cur, wr, wc, fr, fq); }
            const char* a1 = cA + (size_t)(t + 1) * kstep;
            const char* a2 = last ? nA : cA + (size_t)(t + 2) * kstep; const char* b2 = last ? nB : cB + (size_t)(t + 2) * kstep;
            const char* a3 = a2 + kstep; const char* b3 = b2 + kstep;
            unsigned vo2[2][2];
#pragma unroll
            for (int h = 0; h < 2; ++h)
#pragma unroll
                for (int i = 0; i < 2; ++i) vo2[h][i] = (Sched::GATHER && last && has_next) ? voffAn[h][i] : voffA[h][i];
            PG8_LDB(B0, 0, 0); PG8_LDB(B1, 0, 1); PG8_SCHED; PG8_LDA(At, 0, 0); PG8_STAGE_A(PG8_SA(1, 1), a1, voffA, 1);
            PG8_WAIT_V(8); PG8_WAIT_L(0); PG8_BAR; PG8_MMA(0, 0, At, B0); PG8_MMA(0, 1, At, B1); PG8_BAR; PG8_SCHED;
            PG8_LDA(At, 0, 1); PG8_STAGE_B(PG8_SB(0, 0), b2); PG8_STAGE_B(PG8_SB(0, 1), b2 + hstep); PG8_STAGE_A(PG8_SA(0, 0), a2, vo2, 0);
            PG8_WAIT_V(8); PG8_WAIT_L(0); PG8_BAR; PG8_MMA(1, 0, At, B0); PG8_MMA(1, 1, At, B1); PG8_BAR; PG8_SCHED;
            PG8_LDB(B0, 1, 0); PG8_LDB(B1, 1, 1); PG8_SCHED; PG8_LDA(At, 1, 0); PG8_STAGE_A(PG8_SA(0, 1), a2, vo2, 1);
            PG8_WAIT_V(8); PG8_WAIT_L(0); PG8_BAR; PG8_MMA(0, 0, At, B0); PG8_MMA(0, 1, At, B1); PG8_BAR; PG8_SCHED;
            PG8_LDA(At, 1, 1); PG8_STAGE_B(PG8_SB(1, 0), b3); PG8_STAGE_B(PG8_SB(1, 1), b3 + hstep); PG8_STAGE_A(PG8_SA(1, 0), a3, vo2, 0);
            PG8_WAIT_V(8); PG8_WAIT_L(0); PG8_BAR; PG8_MMA(1, 0, At, B0); PG8_MMA(1, 1, At, B1); PG8_BAR; PG8_SCHED;
        }
        if constexpr (ALIGN_EPI) { if (wr == 0) PG8_BAR; }
        E(acc, cur, ui, wr, wc, fr, fq);
        if (!has_next) break;
#pragma unroll
        for (int a = 0; a < 2; ++a)
#pragma unroll
            for (int b = 0; b < 2; ++b)
#pragma unroll
                for (int m = 0; m < 4; ++m)
#pragma unroll
                    for (int n = 0; n < 2; ++n) acc[a][b][m][n] = (f32x4){0.f, 0.f, 0.f, 0.f};
        cur = nxt; cA = nA; cB = nB; ++ui;
        if constexpr (Sched::GATHER) {
#pragma unroll
            for (int h = 0; h < 2; ++h)
#pragma unroll
                for (int i = 0; i < 2; ++i) voffA[h][i] = voffAn[h][i]; }
        if constexpr (ALIGN_EPI) { if (wr == 1) PG8_BAR; }
    }
    PG8_WAIT_V(0);
    if constexpr (!ALIGN_EPI) { if (wr == 0) PG8_BAR; }
    PG8_BAR;
#undef PG8_SA
#undef PG8_SB
#undef PG8_STAGE_A
#undef PG8_STAGE_B
#undef PG8_LDA
#undef PG8_LDB
#undef PG8_MMA
#undef PG8_WAIT_V
#undef PG8_WAIT_L
#undef PG8_BAR
#undef PG8_SCHED
}
}

struct FEpiP1 {
    static constexpr bool PERM = true, MID = false;
    bf16_t *yab, *vg, *kv, *ga, *gb;
    __device__ __forceinline__ void mid(f32x4 (&)[2][2][4][2], const pg8::Unit&, int, int, int, int) const {}
    __device__ __forceinline__ void operator()(const f32x4 (&acc)[2][2][4][2], const pg8::Unit& u, int, int wr, int wc, int fr, int fq) const {
        const int pn = u.pn; bf16_t* base; int ldc, c0, act;
        if (pn < 2) { base = yab; ldc = 1024; c0 = 256 * pn; act = 1; }
        else if (pn < 4) { base = vg; ldc = 512; c0 = 256 * (pn - 2); act = 1; }
        else if (pn < 6) { base = yab; ldc = 1024; c0 = 512 + 256 * (pn - 4); act = 2; }
        else if (pn < 10) { base = kv; ldc = 1024; c0 = 256 * (pn - 6); act = 0; }
        else if (pn < 14) { base = ga; ldc = 1024; c0 = 256 * (pn - 10); act = 3; }
        else { base = gb; ldc = 1024; c0 = 256 * (pn - 14); act = 3; }
        const int col0 = c0 + wc * 32 + 8 * fq;
#pragma unroll
        for (int ai = 0; ai < 2; ++ai)
#pragma unroll
            for (int m = 0; m < 4; ++m) { bf16_t* rowp = base + (size_t)(u.row0 + ai * 128 + wr * 64 + m * 16 + fr) * ldc + col0;
#pragma unroll
                for (int bj = 0; bj < 2; ++bj) { float v[8];
#pragma unroll
                    for (int k = 0; k < 4; ++k) { v[k] = acc[ai][bj][m][0][k]; v[4 + k] = acc[ai][bj][m][1][k]; }
                    if (act == 1) {
#pragma unroll
                        for (int k = 0; k < 8; ++k) v[k] = gelu_fast(v[k]); }
                    else if (act == 2) {
#pragma unroll
                        for (int k = 0; k < 8; ++k) v[k] *= QSCALE; }
                    else if (act == 3) {
#pragma unroll
                        for (int k = 0; k < 8; ++k) v[k] = sigmoid_fast(v[k]); }
                    u32x4 w; w.x = cvt_pk_bf16(v[0], v[1]); w.y = cvt_pk_bf16(v[2], v[3]); w.z = cvt_pk_bf16(v[4], v[5]); w.w = cvt_pk_bf16(v[6], v[7]);
                    *(u32x4*)(rowp + bj * 128) = w; } }
    }
};


struct FEpiP3 {
    static constexpr bool PERM = true, MID = true;
    bf16_t* ga; const bf16_t* gb;
    __device__ __forceinline__ void mid(f32x4 (&acc)[2][2][4][2], const pg8::Unit& u, int wr, int wc, int fr, int fq) const {
        unsigned ro0 = (unsigned)(u.row0 + wr * 64 + fr) * 1024u + (unsigned)(u.pn * 256 + wc * 32 + 8 * fq); asm volatile("" : "+v"(ro0));
#pragma unroll
        for (int ai = 0; ai < 2; ++ai)
#pragma unroll
            for (int m = 0; m < 4; ++m) { const size_t ro = (size_t)(ro0 + (unsigned)(ai * 128 + m * 16) * 1024u);
#pragma unroll
                for (int bj = 0; bj < 2; ++bj) { const u32x4 a = *(const u32x4*)(ga + ro + bj * 128), b = *(const u32x4*)(gb + ro + bj * 128);
                    const unsigned aw[4] = {a.x, a.y, a.z, a.w}, bw[4] = {b.x, b.y, b.z, b.w};
#pragma unroll
                    for (int k = 0; k < 4; ++k) { const float r0 = bflo(aw[k]) * fast_rcp(fmaxf(bflo(bw[k]), 1e-30f)), r1 = bfhi(aw[k]) * fast_rcp(fmaxf(bfhi(bw[k]), 1e-30f));
                        acc[ai][bj][m][k >> 1][(k & 1) * 2] *= r0; acc[ai][bj][m][k >> 1][(k & 1) * 2 + 1] *= r1; } }
                asm volatile("" : "+v"(acc[ai][0][m][0]), "+v"(acc[ai][0][m][1]), "+v"(acc[ai][1][m][0]), "+v"(acc[ai][1][m][1]) :: "memory"); }
    }
    __device__ __forceinline__ void operator()(const f32x4 (&acc)[2][2][4][2], const pg8::Unit& u, int, int wr, int wc, int fr, int fq) const {
        unsigned ro0 = (unsigned)(u.row0 + wr * 64 + fr) * 1024u + (unsigned)(u.pn * 256 + wc * 32 + 8 * fq); asm volatile("" : "+v"(ro0));
#pragma unroll
        for (int ai = 0; ai < 2; ++ai)
#pragma unroll
            for (int m = 0; m < 4; ++m) { const size_t ro = (size_t)(ro0 + (unsigned)(ai * 128 + m * 16) * 1024u);
#pragma unroll
                for (int bj = 0; bj < 2; ++bj) { const u32x4 b = *(const u32x4*)(gb + ro + bj * 128); const unsigned bw[4] = {b.x, b.y, b.z, b.w}; unsigned ow[4];
#pragma unroll
                    for (int k = 0; k < 4; ++k) ow[k] = cvt_pk_bf16(acc[ai][bj][m][k >> 1][(k & 1) * 2] * fmaxf(bflo(bw[k]), 1e-30f), acc[ai][bj][m][k >> 1][(k & 1) * 2 + 1] * fmaxf(bfhi(bw[k]), 1e-30f));
                    u32x4 w; w.x = ow[0]; w.y = ow[1]; w.z = ow[2]; w.w = ow[3]; *(u32x4*)(ga + ro + bj * 128) = w; } }
    }
};
struct FEpiP4 {
    static constexpr bool PERM = false, MID = false;
    const bf16_t* h; float* z;
    __device__ __forceinline__ void mid(f32x4 (&)[2][2][4][2], const pg8::Unit&, int, int, int, int) const {}
    __device__ __forceinline__ void operator()(const f32x4 (&acc)[2][2][4][2], const pg8::Unit& u, int, int wr, int wc, int fr, int fq) const {
        const int col0 = u.pn * 256 + wc * 32 + 4 * fq;
#pragma unroll
        for (int ai = 0; ai < 2; ++ai)
#pragma unroll
            for (int m = 0; m < 4; ++m) { const size_t ro = (size_t)(u.row0 + ai * 128 + wr * 64 + m * 16 + fr) * 1024 + col0;
#pragma unroll
                for (int bj = 0; bj < 2; ++bj)
#pragma unroll
                    for (int n = 0; n < 2; ++n) { const u32x2 hw = *(const u32x2*)(h + ro + bj * 128 + n * 16); const f32x4 a = acc[ai][bj][m][n];
                        f32x4 o; o.x = ALPHA * bflo(hw.x) + a.x; o.y = ALPHA * bfhi(hw.x) + a.y; o.z = ALPHA * bflo(hw.y) + a.z; o.w = ALPHA * bfhi(hw.y) + a.w;
                        *(f32x4*)(z + ro + bj * 128 + n * 16) = o; } }
    }
};
struct FEpiBf16 {
    static constexpr bool PERM = true, MID = false;
    bf16_t* O; int ldc, pn0;
    __device__ __forceinline__ void mid(f32x4 (&)[2][2][4][2], const pg8::Unit&, int, int, int, int) const {}
    __device__ __forceinline__ void operator()(const f32x4 (&acc)[2][2][4][2], const pg8::Unit& u, int, int wr, int wc, int fr, int fq) const {
        const int col0 = (u.pn - pn0) * 256 + wc * 32 + 8 * fq;
#pragma unroll
        for (int ai = 0; ai < 2; ++ai)
#pragma unroll
            for (int m = 0; m < 4; ++m) { bf16_t* rowp = O + (size_t)(u.row0 + ai * 128 + wr * 64 + m * 16 + fr) * ldc + col0;
#pragma unroll
                for (int bj = 0; bj < 2; ++bj) { const f32x4 v0 = acc[ai][bj][m][0], v1 = acc[ai][bj][m][1];
                    u32x4 w; w.x = cvt_pk_bf16(v0.x, v0.y); w.y = cvt_pk_bf16(v0.z, v0.w); w.z = cvt_pk_bf16(v1.x, v1.y); w.w = cvt_pk_bf16(v1.z, v1.w);
                    *(u32x4*)(rowp + bj * 128) = w; } }
    }
};
struct FEpiP6 {
    static constexpr bool PERM = true, MID = false;
    bf16_t* hbx; const LAS float* gw;
    __device__ __forceinline__ void mid(f32x4 (&)[2][2][4][2], const pg8::Unit&, int, int, int, int) const {}
    __device__ __forceinline__ void operator()(const f32x4 (&acc)[2][2][4][2], const pg8::Unit& u, int ui, int wr, int wc, int fr, int fq) const {
        const int col0 = u.pn * 128 + wc * 32 + 8 * fq;
#pragma unroll
        for (int ai = 0; ai < 2; ++ai)
#pragma unroll
            for (int m = 0; m < 4; ++m) { const int rl = ai * 128 + wr * 64 + m * 16 + fr; const float w = gw[ui * 256 + rl];
                float o[8];
#pragma unroll
                for (int k = 0; k < 8; ++k) { const float g = acc[ai][0][m][k >> 2][k & 3], up = acc[ai][1][m][k >> 2][k & 3]; o[k] = w * g * fast_rcp(1.f + fast_exp2(-1.4426950408889634f * g)) * up; }
                u32x4 wv; wv.x = cvt_pk_bf16(o[0], o[1]); wv.y = cvt_pk_bf16(o[2], o[3]); wv.z = cvt_pk_bf16(o[4], o[5]); wv.w = cvt_pk_bf16(o[6], o[7]);
                *(u32x4*)(hbx + (size_t)(u.row0 + rl) * EFF + col0) = wv; }
    }
};
struct FEpiP9 {
    static constexpr bool PERM = false, MID = false;
    const bf16_t *r, *pp; float* r2;
    __device__ __forceinline__ void mid(f32x4 (&)[2][2][4][2], const pg8::Unit&, int, int, int, int) const {}
    __device__ __forceinline__ void operator()(const f32x4 (&acc)[2][2][4][2], const pg8::Unit& u, int, int wr, int wc, int fr, int fq) const {
        const int col0 = u.pn * 256 + wc * 32 + 4 * fq;
#pragma unroll
        for (int ai = 0; ai < 2; ++ai)
#pragma unroll
            for (int m = 0; m < 4; ++m) { const size_t ro = (size_t)(u.row0 + ai * 128 + wr * 64 + m * 16 + fr) * 1024 + col0;
#pragma unroll
                for (int bj = 0; bj < 2; ++bj)
#pragma unroll
                    for (int n = 0; n < 2; ++n) { const u32x2 rw = *(const u32x2*)(r + ro + bj * 128 + n * 16), pw = *(const u32x2*)(pp + ro + bj * 128 + n * 16); const f32x4 a = acc[ai][bj][m][n];
                        f32x4 o; o.x = bflo(rw.x) + sigmoid_fast(a.x) * bflo(pw.x); o.y = bfhi(rw.x) + sigmoid_fast(a.y) * bfhi(pw.x);
                        o.z = bflo(rw.y) + sigmoid_fast(a.z) * bflo(pw.y); o.w = bfhi(rw.y) + sigmoid_fast(a.w) * bfhi(pw.y);
                        *(f32x4*)(r2 + ro + bj * 128 + n * 16) = o; } }
    }
};

__device__ __forceinline__ void moe_tables(LAS unsigned char* lds, const unsigned* cnt, int tid) {
    LAS unsigned char* tile_e = lds + TT_OFF; LAS int* tilebase = (LAS int*)(lds + TT_OFF + 1024);
    if (tid < 64) { const int e = tid; const int n = ((int)cnt[64 * e] + 255) >> 8; int inc = n;
#pragma unroll
        for (int o = 1; o < 64; o <<= 1) { const int y = __shfl_up(inc, o); if (e >= o) inc += y; }
        const int tb = inc - n; tilebase[e] = tb; for (int j = 0; j < n; ++j) tile_e[tb + j] = (unsigned char)e;
        const int tot = __shfl(inc, 63); tile_e[tot + e] = 64; if (e == 0) { tilebase[64] = tot; tilebase[65] = tot + 64; } }
    __syncthreads();
}
struct MoeOrder {
    static constexpr bool GATHER_ = true;
    const LAS unsigned char* tile_e; const LAS int* tilebase; const LAS unsigned* gt;
    const char* A; const char* B; int nwg, G, c, pn0, npn; size_t a_tile_bytes, b_exp_bytes, b_pn_bytes;
    __device__ bool next_(int i, pg8::Unit& u) const {
        const long L = (long)i * G + c; if (L >= nwg) return false;
        int wgid = (int)L; { const int q = nwg / 8, r = nwg % 8, xcd = wgid % 8, off = wgid / 8; wgid = (xcd < r ? xcd * (q + 1) : r * (q + 1) + (xcd - r) * q) + off; }
        const int tau = wgid / npn, pn = pn0 + wgid % npn, e = tile_e[tau];
        u.pm = tau - tilebase[e]; u.pn = pn; u.row0 = tau * 256; u.aux = e;
        u.A = A + (size_t)tau * a_tile_bytes; u.B = B + (size_t)e * b_exp_bytes + (size_t)pn * b_pn_bytes; return true;
    }
};
struct MoeUpOrder : MoeOrder { static constexpr bool GATHER = true;
    __device__ bool next(int i, pg8::Unit& u) const { return next_(i, u); }
    __device__ __forceinline__ void offsets(int i, unsigned (&vo)[2][2], const int (&Rr)[2], const int (&Cc)[2]) const {
#pragma unroll
        for (int h = 0; h < 2; ++h)
#pragma unroll
            for (int k = 0; k < 2; ++k) vo[h][k] = gt[(i & 7) * 256 + h * 128 + Rr[k]] + (unsigned)Cc[k] * 2u; } };
struct MoeDownOrder : MoeOrder { static constexpr bool GATHER = false;
    __device__ bool next(int i, pg8::Unit& u) const { return next_(i, u); }
    __device__ __forceinline__ void offsets(int, unsigned (&)[2][2], const int (&)[2], const int (&)[2]) const {} };

namespace sba {
typedef float f32x16 __attribute__((ext_vector_type(16)));
typedef short s16x4 __attribute__((ext_vector_type(4)));
constexpr int LDS_K = 0, LDS_V = 16384, LDS_OST = 32768, LDS_SGV = 65536;
__device__ __forceinline__ int crow(int r, int hi) { return (r & 3) + 8 * (r >> 2) + 4 * hi; }
__device__ __forceinline__ void pv(f32x16* o, unsigned vb, bf16x8 pa0, bf16x8 pa1, bf16x8 pa2, bf16x8 pa3) {
#pragma unroll
    for (int d0 = 0; d0 < 2; ++d0) { s16x4 lo[4], hi[4];
#pragma unroll
        for (int ks = 0; ks < 4; ++ks) {
            asm volatile("ds_read_b64_tr_b16 %0,%1 offset:%c2" : "=&v"(lo[ks]) : "v"(vb), "i"(d0 * 4096 + ks * 1024) : "memory");
            asm volatile("ds_read_b64_tr_b16 %0,%1 offset:%c2" : "=&v"(hi[ks]) : "v"(vb), "i"(d0 * 4096 + ks * 1024 + 512) : "memory"); }
        asm volatile("s_waitcnt lgkmcnt(0)" ::: "memory"); __builtin_amdgcn_sched_barrier(0);
#define SBA_PK(k) (bf16x8){lo[k][0], lo[k][1], lo[k][2], lo[k][3], hi[k][0], hi[k][1], hi[k][2], hi[k][3]}
        o[d0] = __builtin_amdgcn_mfma_f32_32x32x16_bf16(pa0, SBA_PK(0), o[d0], 0, 0, 0);
        o[d0] = __builtin_amdgcn_mfma_f32_32x32x16_bf16(pa1, SBA_PK(1), o[d0], 0, 0, 0);
        o[d0] = __builtin_amdgcn_mfma_f32_32x32x16_bf16(pa2, SBA_PK(2), o[d0], 0, 0, 0);
        o[d0] = __builtin_amdgcn_mfma_f32_32x32x16_bf16(pa3, SBA_PK(3), o[d0], 0, 0, 0);
#undef SBA_PK
    }
}
__device__ __forceinline__ float other_half(float x) { return __shfl_xor(x, 32); }

__device__ __forceinline__ void attn_unit(LAS unsigned char* lds, bf16_t* YAB, const bf16_t* KV, int b, int h, int qb) {
    const int tid = threadIdx.x, lane = tid & 63, r32 = lane & 31, hi = lane >> 5; const int wid = __builtin_amdgcn_readfirstlane(tid >> 6);
    const size_t rowbase = (size_t)b * SEQ; const int q0 = qb * 256, r0 = q0 + wid * 32;
    const bf16_t* Qw = YAB + (rowbase + r0) * 1024 + 512 + h * 64;
    const bf16_t* Kh = KV + rowbase * 1024 + h * 64; const bf16_t* Vh = Kh + 512;
    const bf16_t* ksrc = Kh + (size_t)lane * 1024 + wid * 8;
    const bf16_t* vsrc = Vh + (size_t)(16 * (wid & 3) + (lane >> 2)) * 1024 + (wid >> 2) * 32 + (lane & 3) * 8;
    LAS unsigned char* kdst = lds + LDS_K + wid * 1024 + lane * 16; LAS unsigned char* vdst = lds + LDS_V + wid * 1024 + lane * 16;
    const unsigned lds0 = (unsigned)(uintptr_t)lds;
    const unsigned vb0 = lds0 + LDS_V + ((lane >> 4) & 1) * 32 + (lane & 3) * 8 + (4 * hi + ((lane & 15) >> 2)) * 64;
    const LAS unsigned char* kp0 = lds + LDS_K + hi * 1024 + r32 * 16;
    bf16x8 qr[4];
#pragma unroll
    for (int d0 = 0; d0 < 4; ++d0) qr[d0] = *(const bf16x8*)(Qw + (size_t)r32 * 1024 + d0 * 16 + hi * 8);
    f32x16 o[2]; o[0] = f32x16{}; o[1] = f32x16{};
    float carry = 0.f;
    const int NT = (q0 + 256) / 64;
    u32x4 kreg = *(const u32x4*)(ksrc + (size_t)(NT - 1) * 64 * 1024), vreg = *(const u32x4*)(vsrc + (size_t)(NT - 1) * 64 * 1024);
    *(LAS u32x4*)kdst = kreg; *(LAS u32x4*)vdst = vreg;
    __syncthreads();
    int cur = 0;
    for (int j = NT - 1; j >= 0; --j) {
        if (j > 0) { kreg = *(const u32x4*)(ksrc + (size_t)(j - 1) * 64 * 1024); vreg = *(const u32x4*)(vsrc + (size_t)(j - 1) * 64 * 1024); }
        const int kb = 64 * j;
        if (kb < r0 + 31) {
            f32x16 p0 = f32x16{}, p1 = f32x16{};
            const LAS unsigned char* kp = kp0 + cur * 8192;
#pragma unroll
            for (int d0 = 0; d0 < 4; ++d0) { const bf16x8 b0 = *(const LAS bf16x8*)(kp + d0 * 2048), b1 = *(const LAS bf16x8*)(kp + d0 * 2048 + 512);
                p0 = __builtin_amdgcn_mfma_f32_32x32x16_bf16(b0, qr[d0], p0, 0, 0, 0); p1 = __builtin_amdgcn_mfma_f32_32x32x16_bf16(b1, qr[d0], p1, 0, 0, 0); }
#pragma unroll
            for (int r = 0; r < 16; ++r) { p0[r] = fast_exp2(fminf(p0[r], 28.f)); p1[r] = fast_exp2(fminf(p1[r], 28.f)); }
            if (kb + 63 >= r0) { const int t = r0 + r32;
#pragma unroll
                for (int r = 0; r < 16; ++r) { const int kv = kb + crow(r, hi); if (kv >= t) p0[r] = 0.f; if (kv + 32 >= t) p1[r] = 0.f; } }
            float lg[8];
#pragma unroll
            for (int g = 0; g < 8; ++g) {
#define SBA_E(k) (g < 4 ? p0[4 * g + (k)] : p1[4 * (g - 4) + (k)])
                const float e0 = SBA_E(0), e1 = SBA_E(1), e2 = SBA_E(2), e3 = SBA_E(3);
                const float f0 = 1.f + e0, f1 = 1.f + e1, f2 = 1.f + e2, f3 = 1.f + e3;
                const float pr2 = f0 * f1, pr3 = pr2 * f2, G = pr3 * f3;
                lg[g] = __builtin_amdgcn_logf(G);
                if (g < 4) { p0[4 * g + 1] = e1 * f0; p0[4 * g + 2] = e2 * pr2; p0[4 * g + 3] = e3 * pr3; } else { p1[4 * (g - 4) + 1] = e1 * f0; p1[4 * (g - 4) + 2] = e2 * pr2; p1[4 * (g - 4) + 3] = e3 * pr3; }
#undef SBA_E
            }
            float suf = carry, tot;
#pragma unroll
            for (int g = 7; g >= 0; --g) { const float og = other_half(lg[g]); const float sincl = suf + lg[g] + (hi == 0 ? og : 0.f); suf += lg[g] + og;
                const float sc = fast_exp2(-sincl);
                if (g < 4) {
#pragma unroll
                    for (int k = 0; k < 4; ++k) p0[4 * g + k] *= sc; } else {
#pragma unroll
                    for (int k = 0; k < 4; ++k) p1[4 * (g - 4) + k] *= sc; } }
            carry = suf; (void)tot;
            u32x4 pw0, pw1, pw2, pw3;
            pw0.x = cvt_pk_bf16(p0[0], p0[1]); pw0.y = cvt_pk_bf16(p0[2], p0[3]); pw0.z = cvt_pk_bf16(p0[4], p0[5]); pw0.w = cvt_pk_bf16(p0[6], p0[7]);
            pw1.x = cvt_pk_bf16(p0[8], p0[9]); pw1.y = cvt_pk_bf16(p0[10], p0[11]); pw1.z = cvt_pk_bf16(p0[12], p0[13]); pw1.w = cvt_pk_bf16(p0[14], p0[15]);
            pw2.x = cvt_pk_bf16(p1[0], p1[1]); pw2.y = cvt_pk_bf16(p1[2], p1[3]); pw2.z = cvt_pk_bf16(p1[4], p1[5]); pw2.w = cvt_pk_bf16(p1[6], p1[7]);
            pw3.x = cvt_pk_bf16(p1[8], p1[9]); pw3.y = cvt_pk_bf16(p1[10], p1[11]); pw3.z = cvt_pk_bf16(p1[12], p1[13]); pw3.w = cvt_pk_bf16(p1[14], p1[15]);
            pv(o, vb0 + cur * 8192, __builtin_bit_cast(bf16x8, pw0), __builtin_bit_cast(bf16x8, pw1), __builtin_bit_cast(bf16x8, pw2), __builtin_bit_cast(bf16x8, pw3));
        }
        if (j > 0) { *(LAS u32x4*)(kdst + (cur ^ 1) * 8192) = kreg; *(LAS u32x4*)(vdst + (cur ^ 1) * 8192) = vreg; }
        __syncthreads();
        cur ^= 1;
    }
    { LAS bf16_t* stg = (LAS bf16_t*)(lds + LDS_OST) + wid * 2048;
#pragma unroll
      for (int r = 0; r < 16; ++r) { const int orow = crow(r, hi);
#pragma unroll
          for (int d0 = 0; d0 < 2; ++d0) stg[orow * 64 + d0 * 32 + r32] = f2bf(o[d0][r]); }
      asm volatile("s_waitcnt lgkmcnt(0)" ::: "memory");
      bf16_t* Ow = YAB + (rowbase + r0) * 1024 + 512 + h * 64;
#pragma unroll
      for (int i = 0; i < 4; ++i) { const int row = i * 8 + (lane >> 3), ch = lane & 7; const u32x4 v = *(const LAS u32x4*)(stg + row * 64 + ch * 8); *(u32x4*)(Ow + (size_t)row * 1024 + ch * 8) = v; } }
    __syncthreads();
}

__device__ __forceinline__ void sg_unit(LAS unsigned char* lds, bf16_t* YAB, const bf16_t* VG, const bf16_t* SGWB, const float* lng, const float* lnb, const float* bs, int blk, int g) {
    const int tid = threadIdx.x, lane = tid & 63, r32 = lane & 31, hi = lane >> 5; const int wid = __builtin_amdgcn_readfirstlane(tid >> 6);
    const size_t t0 = (size_t)blk * 128;
    { const int cl = 8 * (lane - 16 * g); const bool mine = (lane >> 4) == g;
      float gam[8], bet[8];
#pragma unroll
      for (int k = 0; k < 8; ++k) { gam[k] = lng[8 * lane + k]; bet[k] = lnb[8 * lane + k]; }
      for (int i = 0; i < 16; ++i) { const int p = 16 * wid + i;
          const u32x4 raw = *(const u32x4*)(VG + (t0 + p) * SGW + 8 * lane); const unsigned rw[4] = {raw.x, raw.y, raw.z, raw.w};
          float v[8]; float sm = 0.f;
#pragma unroll
          for (int k = 0; k < 4; ++k) { v[2 * k] = bflo(rw[k]); v[2 * k + 1] = bfhi(rw[k]); sm += v[2 * k] + v[2 * k + 1]; }
          const float mean = wave_sum(sm) * (1.f / SGW); float q = 0.f;
#pragma unroll
          for (int k = 0; k < 8; ++k) { v[k] -= mean; q += v[k] * v[k]; }
          const float rstd = 1.f / sqrtf(wave_sum(q) * (1.f / SGW) + LN_EPS);
          if (mine) { float y[8];
#pragma unroll
              for (int k = 0; k < 8; ++k) y[k] = v[k] * rstd * gam[k] + bet[k];
              u32x4 w; w.x = cvt_pk_bf16(y[0], y[1]); w.y = cvt_pk_bf16(y[2], y[3]); w.z = cvt_pk_bf16(y[4], y[5]); w.w = cvt_pk_bf16(y[6], y[7]);
              const int kt = p >> 6, kv = p & 63, dt = cl >> 6, d = cl & 63;
              *(LAS u32x4*)(lds + LDS_SGV + (kt * 2 + dt) * 8192 + ((d >> 5) * 4 + (kv >> 4)) * 1024 + ((kv & 15) * 4 + ((d & 31) >> 3)) * 16) = w; } } }
    __syncthreads();
    { const int ib = wid & 3, dt = wid >> 2; f32x16 o[2]; o[0] = f32x16{}; o[1] = f32x16{};
      const unsigned lds0 = (unsigned)(uintptr_t)lds;
      const unsigned vb0 = lds0 + LDS_SGV + ((lane >> 4) & 1) * 32 + (lane & 3) * 8 + (4 * hi + ((lane & 15) >> 2)) * 64;
      const bf16_t* wrow = SGWB + ((size_t)g * 128 + 32 * ib + r32) * 128;
      const int nkt = ib < 2 ? 1 : 2;
      for (int kt = 0; kt < nkt; ++kt) { u32x4 pa[4];
#pragma unroll
          for (int ks = 0; ks < 4; ++ks) { const u32x2 lo = *(const u32x2*)(wrow + 64 * kt + 16 * ks + 4 * hi), hh = *(const u32x2*)(wrow + 64 * kt + 16 * ks + 8 + 4 * hi); pa[ks].x = lo.x; pa[ks].y = lo.y; pa[ks].z = hh.x; pa[ks].w = hh.y; }
          pv(o, vb0 + (kt * 2 + dt) * 8192, __builtin_bit_cast(bf16x8, pa[0]), __builtin_bit_cast(bf16x8, pa[1]), __builtin_bit_cast(bf16x8, pa[2]), __builtin_bit_cast(bf16x8, pa[3])); }
#pragma unroll
      for (int r = 0; r < 16; ++r) { const int i = 32 * ib + crow(r, hi); const float bias = bs[g * 128 + i];
#pragma unroll
          for (int d0 = 0; d0 < 2; ++d0) { bf16_t* yp = YAB + (t0 + i) * 1024 + g * 128 + 64 * dt + 32 * d0 + r32; *yp = f2bf(bf2f(*yp) * (o[d0][r] + bias)); } } }
    __syncthreads();
}
}

struct Frame {
    LAS unsigned char* lds; volatile LAS unsigned* MISC; unsigned* ctl;
    int tid, lane, wave, vcu, G;
};
struct MkArgs { Ptrs P; int ph_lo, ph_hi, li, pad; };

__device__ __forceinline__ void p0_transpose_item(const float* W, int N, int k0, int n0, bf16_t* WT, size_t drow0, int ldk, int dk0, LAS float* scr, int lane) {
#pragma unroll 8
    for (int i = 0; i < 32; ++i) { const int kk = 2 * i + (lane >> 5); scr[kk * 33 + (lane & 31)] = W[(size_t)(k0 + kk) * N + n0 + (lane & 31)]; }
    asm volatile("s_waitcnt lgkmcnt(0)" ::: "memory");
    const int c = lane & 7;
#pragma unroll
    for (int j = 0; j < 4; ++j) { const int n = (lane >> 3) + 8 * j; const LAS float* s = scr + (8 * c) * 33 + n;
        u32x4 o; o.x = cvt_pk_bf16(s[0 * 33], s[1 * 33]); o.y = cvt_pk_bf16(s[2 * 33], s[3 * 33]); o.z = cvt_pk_bf16(s[4 * 33], s[5 * 33]); o.w = cvt_pk_bf16(s[6 * 33], s[7 * 33]);
        *(u32x4*)(WT + (drow0 + n) * ldk + dk0 + k0 + 8 * c) = o; }
    asm volatile("s_waitcnt lgkmcnt(0)" ::: "memory");
}
__device__ __forceinline__ void ln_row_bf16(const float* xrow, const float* g, const float* b, bf16_t* orow, int lane) {
    const f32x4* xr = (const f32x4*)xrow + lane;
    f32x4 v[4]; float s = 0.f;
#pragma unroll
    for (int j = 0; j < 4; ++j) { v[j] = xr[64 * j]; s += (v[j].x + v[j].y) + (v[j].z + v[j].w); }
    const float mean = wave_sum(s) * (1.f / D); float s2 = 0.f;
#pragma unroll
    for (int j = 0; j < 4; ++j) { v[j] = v[j] - mean; s2 += (v[j].x * v[j].x + v[j].y * v[j].y) + (v[j].z * v[j].z + v[j].w * v[j].w); }
    const float rstd = 1.f / sqrtf(wave_sum(s2) * (1.f / D) + LN_EPS);
    u32x2* o8 = (u32x2*)orow + lane;
#pragma unroll
    for (int j = 0; j < 4; ++j) { const f32x4 gg = ((const f32x4*)g)[lane + 64 * j], bb = ((const f32x4*)b)[lane + 64 * j]; const f32x4 y = v[j] * rstd * gg + bb;
        u32x2 w; w.x = cvt_pk_bf16(y.x, y.y); w.y = cvt_pk_bf16(y.z, y.w); o8[64 * j] = w; }
}
__device__ __forceinline__ void p0_prologue(Frame& F, const Ptrs& P) {
    LAS float* scr = (LAS float*)(F.lds + F.wave * 16384);
    const int gw = F.vcu * NWAVES + F.wave, NGW = F.G * NWAVES, lane = F.lane;
    unsigned char* ws = P.ws; unsigned char* ob = (unsigned char*)P.out;
    bf16_t* WIN = (bf16_t*)(ws + WS_WIN); bf16_t* WAB = (bf16_t*)(ws + WS_WAB); bf16_t* WOUT = (bf16_t*)(ws + WS_WOUT); bf16_t* WGU = (bf16_t*)(ws + WS_WGU);
    bf16_t* WD = (bf16_t*)(ob + OUT_WD); bf16_t* WPG = (bf16_t*)(ob + OUT_WPG); bf16_t* WPP = (bf16_t*)(ob + OUT_WPP);
    constexpr int I_IN = 16 * 144, I_AB = 8 * 32, I_OUT = 16 * 32, I_GU = 16 * 8, I_D = 4 * 32, I_PP = 4 * 32;
    constexpr int O_IN = 0, O_A = O_IN + I_IN, O_B = O_A + I_AB, O_OUT = O_B + I_AB, O_MG = O_OUT + I_OUT, O_MU = O_MG + 65 * I_GU, O_MD = O_MU + 65 * I_GU, O_PG = O_MD + 65 * I_D, O_PPJ = O_PG + I_OUT, NITEMS = O_PPJ + I_PP;
    for (int it = gw; it < NITEMS; it += NGW) {
        if (it < O_A) { const int r = it - O_IN, kb = r / 144, nb = r % 144; p0_transpose_item(P.w_in, NPROJ, 64 * kb, 32 * nb, WIN, 32 * nb, 1024, 0, scr, lane); }
        else if (it < O_B) { const int r = it - O_A, kb = r / 32, nb = r % 32; p0_transpose_item(P.w_a, D, 64 * kb, 32 * nb, WAB, 32 * nb, 1024, 0, scr, lane); }
        else if (it < O_OUT) { const int r = it - O_B, kb = r / 32, nb = r % 32; p0_transpose_item(P.w_b, D, 64 * kb, 32 * nb, WAB, 32 * nb, 1024, 512, scr, lane); }
        else if (it < O_MG) { const int r = it - O_OUT, kb = r / 32, nb = r % 32; p0_transpose_item(P.w_out, D, 64 * kb, 32 * nb, WOUT, 32 * nb, 1024, 0, scr, lane); }
        else if (it < O_MD) {
            const bool up = it >= O_MU; const int r = it - (up ? O_MU : O_MG), e = r / I_GU, q = r % I_GU, kb = q / 8, nb = q % 8;
            const float* W = e < NEXP ? (up ? P.moe_u : P.moe_g) + (size_t)e * D * EFF : (up ? P.sh_u : P.sh_g);
            const int n0 = 32 * nb; const size_t drow = (size_t)e * 512 + (n0 >> 7) * 256 + (up ? 128 : 0) + (n0 & 127);
            p0_transpose_item(W, EFF, 64 * kb, n0, WGU, drow, 1024, 0, scr, lane); }
        else if (it < O_PG) { const int r = it - O_MD, e = r / I_D, q = r % I_D, kb = q / 32, nb = q % 32;
            const float* W = e < NEXP ? P.moe_d + (size_t)e * EFF * D : P.sh_d;
            p0_transpose_item(W, D, 64 * kb, 32 * nb, WD, (size_t)e * 1024 + 32 * nb, 256, 0, scr, lane); }
        else if (it < O_PPJ) { const int r = it - O_PG, kb = r / 32, nb = r % 32; p0_transpose_item(P.ple_gate, D, 64 * kb, 32 * nb, WPG, 32 * nb, 1024, 0, scr, lane); }
        else { const int r = it - O_PPJ, kb = r / 32, nb = r % 32; p0_transpose_item(P.ple_proj, D, 64 * kb, 32 * nb, WPP, 32 * nb, 256, 0, scr, lane); }
    }
    bf16_t* HB = (bf16_t*)(ws + WS_HB);
    for (int m = gw; m < T; m += NGW) ln_row_bf16(P.x + (size_t)m * D, P.ln_in_g, P.ln_in_b, HB + (size_t)m * D, lane);
    { bf16_t* PB = (bf16_t*)(ob + OUT_PB); const size_t n8 = (size_t)T * PLE / 8;
      for (size_t i = (size_t)(F.vcu * NTHREADS + F.tid); i < n8; i += (size_t)F.G * NTHREADS) { const f32x4 a = ((const f32x4*)P.p)[2 * i], b = ((const f32x4*)P.p)[2 * i + 1];
          u32x4 w; w.x = cvt_pk_bf16(a.x, a.y); w.y = cvt_pk_bf16(a.z, a.w); w.z = cvt_pk_bf16(b.x, b.y); w.w = cvt_pk_bf16(b.z, b.w); ((u32x4*)PB)[i] = w; } }
    { bf16_t* SGWB = (bf16_t*)(ws + WS_SGW);
      for (int i = F.vcu * NTHREADS + F.tid; i < 4 * 128 * 128; i += F.G * NTHREADS) { const int ii = (i >> 7) & 127, j = i & 127; SGWB[i] = ((j >> 6) <= (ii >> 6)) ? f2bf(P.sg_w_s[i]) : (bf16_t)0; } }
}

constexpr int NPHASE = 13;
__global__ void __launch_bounds__(NTHREADS, 2) mk_fwd(MkArgs args) {
    extern __shared__ __attribute__((aligned(16))) unsigned char lds_raw[];
    Frame F;
    F.lds = (LAS unsigned char*)lds_raw;
    F.MISC = (volatile LAS unsigned*)(F.lds + MISC_OFF);
    F.tid = threadIdx.x; F.lane = F.tid & 63; F.wave = __builtin_amdgcn_readfirstlane(F.tid >> 6);
    F.G = gridDim.x; { const int bx = blockIdx.x; F.vcu = (F.G % 8 == 0) ? (bx % 8) * (F.G / 8) + bx / 8 : bx; }
    const Ptrs& P = args.P;
    unsigned char* ws = P.ws;
    F.ctl = (unsigned*)(ws + WS_CTL);
    for (int u = F.tid; u < (GT_OFF - LDSCTL_OFF) / 4; u += NTHREADS) ((LAS unsigned*)(F.lds + LDSCTL_OFF))[u] = 0u;
    __syncthreads();
    const int lo = args.ph_lo, hi = args.ph_hi;
    const bool multi = (hi - lo) > 1;
    XcdBarrier bar; bar.bar = F.ctl + CW_BAR + args.li * XCD_BAR_WORDS; bar.x = 0; bar.st = nullptr;
    if (multi) bar = xcd_barrier_post(F.ctl + CW_BAR + args.li * XCD_BAR_WORDS, F.MISC + 8);
#ifndef PHMASK
#define PHMASK 0xFFFFu
#endif
#define IN(k) (((PHMASK >> (k)) & 1u) && lo <= (k) && (k) < hi)
#define SEAM(k) do { if (IN(k) && IN((k) + 1)) xcd_barrier(bar); } while (0)
    bf16_t* HB = (bf16_t*)(ws + WS_HB); bf16_t* YAB = (bf16_t*)(ws + WS_YAB); bf16_t* VG = (bf16_t*)(ws + WS_VG); bf16_t* KV = (bf16_t*)(ws + WS_KV);
    bf16_t* GA = (bf16_t*)(ws + WS_GA); bf16_t* GB = (bf16_t*)(ws + WS_GB);
    if (IN(0)) { p0_prologue(F, P); }
    SEAM(0);
    if (IN(1)) {
        pg8::DenseOrder S; S.init(HB, ws + WS_WIN, T, NPROJ, D, F.G, (int)blockIdx.x);
        FEpiP1 E; E.yab = YAB; E.vg = VG; E.kv = KV; E.ga = GA; E.gb = GB;
        pg8::gemm_phase<FEpiP1, pg8::DenseOrder, true>(F.lds, D, S, E);
    }
    SEAM(1);
    if (IN(2)) {
        for (int u = F.vcu; u < 512; u += F.G) { sba::sg_unit(F.lds, YAB, VG, (const bf16_t*)(ws + WS_SGW), P.sg_ln_g, P.sg_ln_b, P.sg_b_s, u >> 2, u & 3); }
        for (int pi = F.vcu; pi < 256; pi += F.G) { const int bh = pi >> 2, sidx = pi & 3;
            sba::attn_unit(F.lds, YAB, KV, bh >> 3, bh & 7, 7 - sidx); sba::attn_unit(F.lds, YAB, KV, bh >> 3, bh & 7, sidx); }
    }
    SEAM(2);
    if (IN(3)) {
        pg8::DenseOrder S; S.init(YAB, ws + WS_WAB, T, D, D, F.G, (int)blockIdx.x);
        FEpiP3 E; E.ga = GA; E.gb = GB;
        pg8::gemm_phase<FEpiP3, pg8::DenseOrder, false>(F.lds, D, S, E);
    }
    SEAM(3);
    if (IN(4)) {
        pg8::DenseOrder S; S.init(GA, ws + WS_WOUT, T, D, D, F.G, (int)blockIdx.x);
        FEpiP4 E; E.h = HB; E.z = (float*)(ws + WS_Z);
        pg8::gemm_phase<FEpiP4, pg8::DenseOrder, false>(F.lds, D, S, E);
    }
    SEAM(4);
    unsigned char* ob = (unsigned char*)P.out;
    unsigned* CNT = F.ctl + CW_CNT; int* ROWTOK = (int*)(ob + OUT_ROWTOK); float* ROWW = (float*)(ob + OUT_ROWW); int* TOKSLOT = (int*)(ob + OUT_TOKSLOT);
    if (IN(5)) { for (int blk = blockIdx.x; blk < T / 64; blk += F.G) { route_block(lds_raw, blk, (const float*)(ws + WS_Z), P.ln1_g, P.ln1_b, HB, P.router_w, P.router_bias, CNT, ROWTOK, ROWW, TOKSLOT); __syncthreads(); } }
    SEAM(5);
    bf16_t* HBX = (bf16_t*)(ws + WS_HBX); bf16_t* YB = (bf16_t*)(ws + WS_Y);
    const LAS unsigned char* tile_e = F.lds + TT_OFF; const LAS int* tilebase = (const LAS int*)(F.lds + TT_OFF + 1024);
    if (IN(6)) {
        moe_tables(F.lds, CNT, F.tid);
        MoeUpOrder S; S.tile_e = tile_e; S.tilebase = tilebase; S.gt = (const LAS unsigned*)(F.lds + GT_OFF); S.A = (const char*)HB; S.B = (const char*)(ws + WS_WGU);
        S.nwg = tilebase[65] * 2; S.G = F.G; S.c = (int)blockIdx.x; S.pn0 = 0; S.npn = 2; S.a_tile_bytes = 0; S.b_exp_bytes = (size_t)512 * 1024 * 2; S.b_pn_bytes = (size_t)256 * 1024 * 2;
        { LAS unsigned* gt = (LAS unsigned*)(F.lds + GT_OFF); LAS float* gwt = (LAS float*)(F.lds + GW_OFF); pg8::Unit u;
          for (int i = 0; i < 8; ++i) { if (!S.next(i, u)) break;
              if (F.tid < 256) { const int e = u.aux, p = u.pm * 256 + F.tid; int tok; float w;
                  if (e < NEXP) { const bool ok = p < (int)CNT[64 * e]; tok = ok ? ROWTOK[(size_t)e * ECAP + p] : 0; w = ok ? ROWW[(size_t)e * ECAP + p] : 0.f; } else { tok = p; w = 1.f; }
                  gt[i * 256 + F.tid] = (unsigned)tok * 2048u; gwt[i * 256 + F.tid] = w; } }
          __syncthreads(); }
        FEpiP6 E; E.hbx = HBX; E.gw = (const LAS float*)(F.lds + GW_OFF);
        pg8::gemm_phase<FEpiP6, MoeUpOrder, true>(F.lds, D, S, E);
    }
    SEAM(6);
#pragma unroll
    for (int chunk = 0; chunk < 2; ++chunk) {
        if (IN(7 + 2 * chunk)) {
            moe_tables(F.lds, CNT, F.tid);
            MoeDownOrder S; S.tile_e = tile_e; S.tilebase = tilebase; S.gt = nullptr; S.A = (const char*)HBX; S.B = (const char*)(ob + OUT_WD);
            S.nwg = tilebase[65] * 2; S.G = F.G; S.c = (int)blockIdx.x; S.pn0 = 2 * chunk; S.npn = 2; S.a_tile_bytes = (size_t)256 * EFF * 2; S.b_exp_bytes = (size_t)1024 * EFF * 2; S.b_pn_bytes = (size_t)256 * EFF * 2;
            FEpiBf16 E; E.O = YB; E.ldc = 512; E.pn0 = 2 * chunk;
            pg8::gemm_phase<FEpiBf16, MoeDownOrder, true>(F.lds, EFF, S, E);
        }
        SEAM(7 + 2 * chunk);
        if (IN(8 + 2 * chunk)) {
            moe_tables(F.lds, CNT, F.tid);
            const int gw = F.vcu * NWAVES + F.wave, NGW = F.G * NWAVES, lane = F.lane; const int shared_row0 = tilebase[64] * 256;
            for (int t = gw; t < T; t += NGW) {
                int myrow = 0; if (lane < 8) { const int sl = TOKSLOT[t * 8 + lane]; myrow = tilebase[sl >> 16] * 256 + (sl & 0xffff); } else if (lane == 8) myrow = shared_row0 + t;
                bf16_t* hp = HB + (size_t)t * D + chunk * 512 + 8 * lane; const u32x4 hv = *(const u32x4*)hp; const unsigned hw[4] = {hv.x, hv.y, hv.z, hv.w};
                float a[8];
#pragma unroll
                for (int k = 0; k < 4; ++k) { a[2 * k] = ALPHA * bflo(hw[k]); a[2 * k + 1] = ALPHA * bfhi(hw[k]); }
#pragma unroll
                for (int j = 0; j < 9; ++j) { const int row = __shfl(myrow, j); const u32x4 yv = *(const u32x4*)(YB + (size_t)row * 512 + 8 * lane); const unsigned yw[4] = {yv.x, yv.y, yv.z, yv.w};
#pragma unroll
                    for (int k = 0; k < 4; ++k) { a[2 * k] += bflo(yw[k]); a[2 * k + 1] += bfhi(yw[k]); } }
                u32x4 o; o.x = cvt_pk_bf16(a[0], a[1]); o.y = cvt_pk_bf16(a[2], a[3]); o.z = cvt_pk_bf16(a[4], a[5]); o.w = cvt_pk_bf16(a[6], a[7]); *(u32x4*)hp = o;
            }
        }
        SEAM(8 + 2 * chunk);
    }
    if (IN(11)) {
        { pg8::DenseOrder S; S.init(ob + OUT_PB, ob + OUT_WPP, T, D, PLE, F.G, (int)blockIdx.x);
          FEpiBf16 E; E.O = (bf16_t*)(ws + WS_PP); E.ldc = 1024; E.pn0 = 0;
          pg8::gemm_phase<FEpiBf16, pg8::DenseOrder, false>(F.lds, PLE, S, E); }
        asm volatile("s_waitcnt vmcnt(0)" ::: "memory"); __syncthreads();
        { pg8::DenseOrder S; S.init(HB, ob + OUT_WPG, T, D, D, F.G, (int)blockIdx.x);
          FEpiP9 E; E.r = HB; E.pp = (const bf16_t*)(ws + WS_PP); E.r2 = (float*)(ws + WS_R2);
          pg8::gemm_phase<FEpiP9, pg8::DenseOrder, false>(F.lds, D, S, E); }
    }
    SEAM(11);
    if (IN(12)) {
        const int gw = F.vcu * NWAVES + F.wave, NGW = F.G * NWAVES, lane = F.lane; const float* R2 = (const float*)(ws + WS_R2);
        for (int m = gw; m < T; m += NGW) {
            const f32x4* xr = (const f32x4*)(R2 + (size_t)m * D) + lane; f32x4 v[4]; float sm = 0.f;
#pragma unroll
            for (int j = 0; j < 4; ++j) { v[j] = xr[64 * j]; sm += (v[j].x + v[j].y) + (v[j].z + v[j].w); }
            const float mean = wave_sum(sm) * (1.f / D); float s2 = 0.f;
#pragma unroll
            for (int j = 0; j < 4; ++j) { v[j] = v[j] - mean; s2 += (v[j].x * v[j].x + v[j].y * v[j].y) + (v[j].z * v[j].z + v[j].w * v[j].w); }
            const float rstd = 1.f / sqrtf(wave_sum(s2) * (1.f / D) + LN_EPS);
            f32x4* orow = (f32x4*)(P.out + (size_t)m * D) + lane;
#pragma unroll
            for (int j = 0; j < 4; ++j) { const f32x4 gg = ((const f32x4*)P.ln2_g)[lane + 64 * j], bb = ((const f32x4*)P.ln2_b)[lane + 64 * j]; orow[64 * j] = v[j] * rstd * gg + bb; }
        }
    }
#undef IN
#undef SEAM
}
#ifndef FASTMASK
#define FASTMASK 0x1FFFu
#endif
static int g_grid = 0;
static void launch_mk(const Ptrs& P, int lo, int hi, int li, hipStream_t stream) {
    if (g_grid == 0) {
        int dev = 0, cus = 0; (void)hipGetDevice(&dev); (void)hipDeviceGetAttribute(&cus, hipDeviceAttributeMultiprocessorCount, dev);
        (void)hipFuncSetAttribute((const void*)mk_fwd, hipFuncAttributeMaxDynamicSharedMemorySize, LDS_BYTES);
        g_grid = cus > 0 ? cus : 256;
    }
    MkArgs a; memset(&a, 0, sizeof(a)); a.P = P; a.ph_lo = lo; a.ph_hi = hi; a.li = li; a.pad = 0;
    hipLaunchKernelGGL(mk_fwd, dim3(g_grid), dim3(NTHREADS), LDS_BYTES, stream, a);
}

extern "C" void kernel_launch(void* const* d_in, const int* in_sizes, int n_in, void* d_out, int out_size, void* d_ws, size_t ws_size, hipStream_t stream) {
    Ptrs P{};
    const float** pp = (const float**)&P;
    for (int i = 0; i < 26; ++i) pp[i] = (const float*)d_in[i];
    P.out = (float*)d_out; P.ws = (unsigned char*)d_ws;
    unsigned char* ws = P.ws; unsigned char* ob = (unsigned char*)d_out;
    bf16_t* HB = (bf16_t*)(ws + WS_HB); bf16_t* YAB = (bf16_t*)(ws + WS_YAB); bf16_t* VG = (bf16_t*)(ws + WS_VG); bf16_t* KV = (bf16_t*)(ws + WS_KV);
    bf16_t* GA = (bf16_t*)(ws + WS_GA); bf16_t* GB = (bf16_t*)(ws + WS_GB); float* Z = (float*)(ws + WS_Z); bf16_t* HBX = (bf16_t*)(ws + WS_HBX);
    float* RACC = (float*)(ws + WS_RACC); float* R2 = (float*)(ws + WS_R2); bf16_t* PPB = (bf16_t*)(ws + WS_PP); float* SCR = (float*)(ws + WS_SCR);
    bf16_t* PB = (bf16_t*)(ob + OUT_PB); int* ROWTOK = (int*)(ob + OUT_ROWTOK); float* ROWW = (float*)(ob + OUT_ROWW); int* TOKSLOT = (int*)(ob + OUT_TOKSLOT);
    unsigned* CTL = (unsigned*)(ws + WS_CTL); unsigned* CNT = CTL + CW_CNT;
    hipMemsetAsync(ws + WS_CTL, 0, 1 * MiB, stream);
#define FAST(k) ((FASTMASK >> (k)) & 1u)
    int li = 0;
    for (int ph = 0; ph < NPHASE;) {
        if (FAST(ph)) { int hi = ph; while (hi < NPHASE && FAST(hi)) ++hi; launch_mk(P, ph, hi, li++, stream); ph = hi; continue; }
        switch (ph) {
        case 0: n_ln<true><<<T / 4, 256, 0, stream>>>(P.x, P.ln_in_g, P.ln_in_b, HB, T); n_cvt_bf16<<<(T * PLE) / 256, 256, 0, stream>>>(P.p, PB, (size_t)T * PLE); break;
        case 1: { NG g = mkNG(HB, HB, 1024, P.w_in, P.w_in, NPROJ, T, NPROJ, D); EpiP1 e; e.yab = YAB; e.vg = VG; e.kv = KV; e.ga = GA; e.gb = GB;
                  n_gemm<false, EpiP1><<<dim3(NPROJ / 64, T / 64, 1), 256, 0, stream>>>(g, e); } break;
        case 2: n_sg_stats<<<T / 4, 256, 0, stream>>>(VG, SCR);
                n_sg<<<(T * SGW) / 256, 256, 0, stream>>>(YAB, VG, SCR, P.sg_ln_g, P.sg_ln_b, P.sg_w_s, P.sg_b_s);
                n_attn<<<(T * NHEAD) / 4, 256, 0, stream>>>(YAB, KV); break;
        case 3: { NG g = mkNG(YAB, YAB + 512, 1024, P.w_a, P.w_b, D, T, D, 512); EpiP3 e; e.ga = GA; e.gb = GB; n_gemm<true, EpiP3><<<dim3(D / 64, T / 64, 1), 256, 0, stream>>>(g, e); } break;
        case 4: { NG g = mkNG(GA, GA, 1024, P.w_out, P.w_out, D, T, D, D); EpiP4 e; e.h = HB; e.z = Z; n_gemm<false, EpiP4><<<dim3(D / 64, T / 64, 1), 256, 0, stream>>>(g, e); } break;
        case 5: (void)hipFuncSetAttribute((const void*)k_route, hipFuncAttributeMaxDynamicSharedMemorySize, 131072 + 1024 + 8192);
                k_route<<<T / 64, 512, 131072 + 1024 + 8192, stream>>>(Z, P.ln1_g, P.ln1_b, HB, P.router_w, P.router_bias, CNT, ROWTOK, ROWW, TOKSLOT); break;
        case 6: { NG g = mkNG(HB, HB, 1024, nullptr, nullptr, EFF, T, EFF, D); EpiP6 e; e.cnt = CNT; e.rowtok = ROWTOK; e.roww = ROWW; e.hbx = HBX; e.mg = P.moe_g; e.mu = P.moe_u; e.sg = P.sh_g; e.su = P.sh_u; e.e = 0; e.rowbase = 0;
                  n_gemm<true, EpiP6><<<dim3(EFF / 64, T / 64, NEXP + 1), 256, 0, stream>>>(g, e); } break;
        case 7: { n_racc_init<<<(T * D) / 256, 256, 0, stream>>>(HB, RACC);
                  NG g = mkNG(HBX, HBX, EFF, nullptr, nullptr, D, T, D, EFF); EpiP7 e; e.cnt = CNT; e.rowtok = ROWTOK; e.racc = RACC; e.md = P.moe_d; e.sd = P.sh_d; e.e = 0; e.rowbase = 0;
                  n_gemm<false, EpiP7><<<dim3(D / 64, T / 64, NEXP + 1), 256, 0, stream>>>(g, e);
                  n_racc_fin<<<(T * D) / 256, 256, 0, stream>>>(RACC, HB); ph = 10; } break;
        case 11: { NG g = mkNG(PB, PB, PLE, P.ple_proj, P.ple_proj, D, T, D, PLE); EpiPP e; e.pp = PPB; n_gemm<false, EpiPP><<<dim3(D / 64, T / 64, 1), 256, 0, stream>>>(g, e); }
                 { NG g = mkNG(HB, HB, 1024, P.ple_gate, P.ple_gate, D, T, D, D); EpiP9 e; e.r = HB; e.pp = PPB; e.r2 = R2; n_gemm<false, EpiP9><<<dim3(D / 64, T / 64, 1), 256, 0, stream>>>(g, e); } break;
        case 12: n_ln<false><<<T / 4, 256, 0, stream>>>(R2, P.ln2_g, P.ln2_b, P.out, T); break;
        default: break;
        }
        ++ph;
    }
}
```
